# Optimizing an MI355X kernel written in HIP

```python
import jax, jax.numpy as jnp
from jax import lax
import numpy as np

D_MODEL = 1024
BATCH = 8
SEQ = 2048
DEPTH = 1
DEC_BATCH = 128
DEC_SEQ = 4
PAST_LEN = 16384
PAGE_SIZE = 128

MIX_WIDTH = D_MODEL
HG_WIDTH = MIX_WIDTH // 2
CV_WIDTH = MIX_WIDTH - HG_WIDTH
HG_HEADS = 4
HG_DK = HG_WIDTH // HG_HEADS
HG_DV = HG_DK
CV_GROUPS = 8
CV_KERNEL = 31
CV_BUF = CV_KERNEL - 1
D_FF = 4 * D_MODEL
CHUNK = 64
N_IN = 4 * HG_WIDTH + 2 * CV_WIDTH
ALPHA = (2.0 * DEPTH) ** 0.25
BETA = (8.0 * DEPTH) ** -0.25
EPS = 1e-5

kernel_name = 'hymba_hgrn2_conformer_deepnorm_adaln_step'


def _norm(x):
    xf = x.astype(jnp.float32)
    mu = jnp.mean(xf, axis=-1, keepdims=True)
    var = jnp.mean(jnp.square(xf - mu), axis=-1, keepdims=True)
    return ((xf - mu) * lax.rsqrt(var + EPS)).astype(x.dtype)


def _layer_norm(x, g, b):
    return _norm(x) * g + b


def _hgrn2_chunked(q, k, v, logf, S0):
    B, T, H, DK = q.shape
    DV = v.shape[-1]
    c = min(CHUNK, T)
    n = -(-T // c)
    pad = n * c - T
    if pad:
        cfg = ((0, 0), (0, pad), (0, 0), (0, 0))
        q, k, v, logf = (jnp.pad(a, cfg) for a in (q, k, v, logf))

    def blk(a):
        return a.reshape(B, n, c, H, a.shape[-1]).transpose(1, 0, 3, 2, 4)

    q, k, v, logf = blk(q), blk(k), blk(v), blk(logf)
    b = jnp.cumsum(logf, axis=3)
    b_last = b[:, :, :, -1, :]
    qe = q * jnp.exp(b)
    ke = k * jnp.exp(-b)
    kd = k * jnp.exp(b_last[:, :, :, None, :] - b)
    causal = jnp.tril(jnp.ones((c, c), dtype=bool))
    att = jnp.where(causal, jnp.einsum('nbhtk,nbhsk->nbhts', qe, ke), 0.0)
    o_intra = jnp.einsum('nbhts,nbhsv->nbhtv', att, v)

    def step(S, inp):
        qe_c, kd_c, v_c, bl_c = inp
        o_c = jnp.einsum('bhtk,bhkv->bhtv', qe_c, S)
        S = jnp.exp(bl_c)[..., None] * S + jnp.einsum('bhtk,bhtv->bhkv', kd_c, v_c)
        return S, o_c

    S, o_inter = lax.scan(step, S0, (qe, kd, v, b_last))
    o = (o_intra + o_inter).transpose(1, 0, 3, 2, 4).reshape(B, n * c, H, DV)[:, :T]
    return o, S


def _causal_dwconv(u, buf, w, bias):
    full = jnp.concatenate([buf, u], axis=1)
    out = lax.conv_general_dilated(
        full, w[:, None, :], window_strides=(1,), padding='VALID',
        dimension_numbers=('NWC', 'WIO', 'NWC'), feature_group_count=full.shape[-1])
    return out + bias, full[:, -CV_BUF:]


def _layer(x, c, S0, buf, lb, w_in, b_in, hg_norm_w, conv_w, conv_b, gn_g, gn_b,
           w_out, b_out, ln1_g, ln1_b, w_up, b_up, w_down, b_down, ln2_g, ln2_b,
           w_ada, b_ada):
    B, T, _ = x.shape
    mod = jax.nn.silu(c) @ w_ada + b_ada
    sh1, sc1, g1, sh2, sc2, g2 = jnp.split(mod[:, None, :], 6, axis=-1)

    h = x * (1.0 + sc1) + sh1
    z = h @ w_in + b_in
    zq, zf, zi, zg, za, zb = jnp.split(
        z, [HG_WIDTH, 2 * HG_WIDTH, 3 * HG_WIDTH, 4 * HG_WIDTH, 4 * HG_WIDTH + CV_WIDTH], axis=-1)

    heads = lambda a: a.reshape(B, T, HG_HEADS, -1).astype(jnp.float32)
    q = jax.nn.silu(heads(zq))
    lbh = lb.reshape(HG_HEADS, HG_DK)
    f = lbh + (1.0 - lbh) * jax.nn.sigmoid(heads(zf))
    o, S_new = _hgrn2_chunked(q, 1.0 - f, heads(zi), jnp.log(f), S0.astype(jnp.float32))
    o = o * lax.rsqrt(jnp.mean(jnp.square(o), axis=-1, keepdims=True) + EPS)
    o = o * hg_norm_w.astype(jnp.float32) * jax.nn.silu(heads(zg))
    o_a = o.reshape(B, T, HG_WIDTH).astype(x.dtype)

    u = za * jax.nn.sigmoid(zb)
    uc, buf_new = _causal_dwconv(u, buf, conv_w, conv_b)
    un = _norm(uc.reshape(B, T, CV_GROUPS, CV_WIDTH // CV_GROUPS)).reshape(B, T, CV_WIDTH)
    o_b = jax.nn.silu(un * gn_g + gn_b)

    mix = jnp.concatenate([o_a, o_b], axis=-1) @ w_out + b_out
    x = _layer_norm(ALPHA * x + (1.0 + g1) * mix, ln1_g, ln1_b)

    h = x * (1.0 + sc2) + sh2
    ff = jnp.square(jax.nn.relu(h @ w_up + b_up)) @ w_down + b_down
    x = _layer_norm(ALPHA * x + (1.0 + g2) * ff, ln2_g, ln2_b)
    return x, S_new.astype(x.dtype), buf_new


def setup_inputs(seed: int = 0) -> dict:
    key = jax.random.key(seed)
    ks = jax.random.split(key, 32)
    nrm = lambda k, shape, s: jax.random.normal(k, shape, jnp.float32) * s
    return {
        'x_prompt': nrm(ks[0], (BATCH, SEQ, D_MODEL), 1.0),
        'x_sample': nrm(ks[1], (DEC_BATCH, DEC_SEQ, D_MODEL), 1.0),
        'c_prompt': nrm(ks[2], (BATCH, D_MODEL), 1.0),
        'c_sample': nrm(ks[3], (DEC_BATCH, D_MODEL), 1.0),
        'state_hgrn': nrm(ks[4], (DEPTH, DEC_BATCH, HG_HEADS, HG_DK, HG_DV), 0.5),
        'state_conv': nrm(ks[5], (DEPTH, DEC_BATCH, CV_BUF, CV_WIDTH), 0.5),
        'lb_logits': nrm(ks[6], (DEPTH + 1, HG_WIDTH), 0.1),
        'w_in': nrm(ks[7], (DEPTH, D_MODEL, N_IN), D_MODEL ** -0.5),
        'b_in': nrm(ks[8], (DEPTH, N_IN), 0.02),
        'hg_norm_w': 1.0 + nrm(ks[9], (DEPTH, HG_DV), 0.02),
        'conv_w': nrm(ks[10], (DEPTH, CV_KERNEL, CV_WIDTH), CV_KERNEL ** -0.5),
        'conv_b': nrm(ks[11], (DEPTH, CV_WIDTH), 0.02),
        'gn_g': 1.0 + nrm(ks[12], (DEPTH, CV_WIDTH), 0.02),
        'gn_b': nrm(ks[13], (DEPTH, CV_WIDTH), 0.02),
        'w_out': nrm(ks[14], (DEPTH, MIX_WIDTH, D_MODEL), MIX_WIDTH ** -0.5 * BETA),
        'b_out': nrm(ks[15], (DEPTH, D_MODEL), 0.02),
        'ln1_g': 1.0 + nrm(ks[16], (DEPTH, D_MODEL), 0.02),
        'ln1_b': nrm(ks[17], (DEPTH, D_MODEL), 0.02),
        'w_up': nrm(ks[18], (DEPTH, D_MODEL, D_FF), D_MODEL ** -0.5 * BETA),
        'b_up': nrm(ks[19], (DEPTH, D_FF), 0.02),
        'w_down': nrm(ks[20], (DEPTH, D_FF, D_MODEL), D_FF ** -0.5 * BETA),
        'b_down': nrm(ks[21], (DEPTH, D_MODEL), 0.02),
        'ln2_g': 1.0 + nrm(ks[22], (DEPTH, D_MODEL), 0.02),
        'ln2_b': nrm(ks[23], (DEPTH, D_MODEL), 0.02),
        'w_ada': nrm(ks[24], (DEPTH, D_MODEL, 6 * D_MODEL), 0.3 * D_MODEL ** -0.5),
        'b_ada': nrm(ks[25], (DEPTH, 6 * D_MODEL), 0.02),
    }


def reference(x_prompt, x_sample, c_prompt, c_sample, state_hgrn, state_conv, lb_logits,
              w_in, b_in, hg_norm_w, conv_w, conv_b, gn_g, gn_b, w_out, b_out,
              ln1_g, ln1_b, w_up, b_up, w_down, b_down, ln2_g, ln2_b, w_ada, b_ada):
    lbs = jnp.cumsum(jax.nn.softmax(lb_logits.astype(jnp.float32), axis=0), axis=0)
    xp, xs = x_prompt, x_sample
    hp_list, cp_list, hs_list, cs_list = [], [], [], []
    for l in range(DEPTH):
        params = (w_in[l], b_in[l], hg_norm_w[l], conv_w[l], conv_b[l], gn_g[l], gn_b[l],
                  w_out[l], b_out[l], ln1_g[l], ln1_b[l], w_up[l], b_up[l], w_down[l],
                  b_down[l], ln2_g[l], ln2_b[l], w_ada[l], b_ada[l])
        S0p = jnp.zeros((xp.shape[0], HG_HEADS, HG_DK, HG_DV), xp.dtype)
        buf0p = jnp.zeros((xp.shape[0], CV_BUF, CV_WIDTH), xp.dtype)
        xp, Sp, bp = _layer(xp, c_prompt, S0p, buf0p, lbs[l], *params)
        xs, Ss, bs = _layer(xs, c_sample, state_hgrn[l], state_conv[l], lbs[l], *params)
        hp_list.append(Sp); cp_list.append(bp); hs_list.append(Ss); cs_list.append(bs)
    new_hgrn_prompt = jnp.stack(hp_list)
    new_conv_prompt = jnp.stack(cp_list)
    new_hgrn_sample = jnp.stack(hs_list)
    new_conv_sample = jnp.stack(cs_list)
    return (xp, xs, new_hgrn_prompt, new_conv_prompt, new_hgrn_sample, new_conv_sample)
```

```cpp
#include <hip/hip_runtime.h>
#include <hip/hip_cooperative_groups.h>
#include <cstdio>
#include <cstdint>
namespace cg = cooperative_groups;
namespace pg8 {
#define PG8_LAS __attribute__((address_space(3)))
typedef unsigned short bf16_t;
typedef short bf16x8 __attribute__((ext_vector_type(8)));
typedef float f32x4 __attribute__((ext_vector_type(4)));
typedef unsigned u32x4 __attribute__((ext_vector_type(4)));
constexpr int BM = 256, BK = 64, HALF = 128, HTB = HALF * BK * 2  , STAGE_BYTES = 8 * HTB, NXCD = 8, WGM = 8;

__host__ __device__ __forceinline__ int lds_byte(int r, int c) { const int st = (r >> 4) * 2 + (c >> 5), rr = r & 15, cc = c & 31, ob = rr * 64 + cc * 2; return st * 1024 + (ob ^ (((ob >> 9) & 1) << 5)); }
__host__ __device__ __forceinline__ void stage_rc(int b, int& R, int& C) { const int st = b / 1024, sb = b % 1024, swz = sb ^ (((sb >> 9) & 1) << 5); R = (st >> 1) * 16 + swz / 64; C = (st & 1) * 32 + (swz % 64) / 2; }
__host__ __device__ __forceinline__ int perm32(int rho) { const int n = rho >> 4, i = rho & 15; return 8 * (i >> 2) + 4 * n + (i & 3); }

struct Unit { int pm, pn; };
struct Gemm { const bf16_t* A; const bf16_t* Bt; int M, N, K; };

struct StaticOrder {
    int nM, nN, nwg, G, c;
    __host__ __device__ void init(int M, int N, int G_, int c_) { nM = M / BM; nN = N / BM; nwg = nM * nN; G = G_; c = c_; }
    __host__ __device__ bool next(int i, Unit& u) const {
        const long L = (long)i * G + c; if (L >= nwg) return false;
        int wgid = (int)L; { const int q = nwg / NXCD, r = nwg % NXCD, xcd = wgid % NXCD, off = wgid / NXCD; wgid = (xcd < r ? xcd * (q + 1) : r * (q + 1) + (xcd - r) * q) + off; }
        const int nig = WGM * nN, gid = wgid / nig, fm = gid * WGM, gsz = (nM - fm) < WGM ? (nM - fm) : WGM;
        u.pm = fm + ((wgid % nig) % gsz); u.pn = (wgid % nig) / gsz; return true;
    }
    __device__ __forceinline__ void a_ready(const Unit&) const {}
    __device__ __forceinline__ void done(const Unit&) const {}
};
__device__ __forceinline__ unsigned cvt_pk_bf16(float lo, float hi) { unsigned r; asm volatile("v_cvt_pk_bf16_f32 %0, %1, %2" : "=v"(r) : "v"(lo), "v"(hi)); return r; }
typedef float f32x2 __attribute__((ext_vector_type(2)));
__device__ __forceinline__ float sigm(float x) { return __builtin_amdgcn_rcpf(1.f + __expf(-x)); }
__device__ __forceinline__ int mod_row(int r) { return r < 16384 ? (r >> 11) : 8 + ((r - 16384) >> 2); }

struct EpiIn {
    static constexpr bool PERM = true, AFTER_DRAIN = false;
    bf16_t *Q, *U; size_t qvg_stride; float* LF; const float* bias; const float* LB;
    __device__ __forceinline__ void operator()(const f32x4 (&acc)[2][2][4][2], const Unit& u, int wr, int wc, int fr, int fq) const {
        const int pn = u.pn, row0 = u.pm * BM + wr * 64 + fr;
        if (pn >= 8) {
            const int cj = 128 * (pn - 8) + wc * 32 + 8 * fq;
            f32x4 ba[2], bb[2];
#pragma unroll
            for (int n = 0; n < 2; ++n) { ba[n] = *(const f32x4*)(bias + 2048 + cj + 4 * n); bb[n] = *(const f32x4*)(bias + 2560 + cj + 4 * n); }
#pragma unroll
            for (int ai = 0; ai < 2; ++ai)
#pragma unroll
                for (int m = 0; m < 4; ++m) {
                    const size_t row = (size_t)(row0 + ai * HALF + m * 16);
                    float o[8];
#pragma unroll
                    for (int n = 0; n < 2; ++n)
#pragma unroll
                        for (int i = 0; i < 4; ++i) { const float a = acc[ai][0][m][n][i] + ba[n][i], b = acc[ai][1][m][n][i] + bb[n][i]; o[4 * n + i] = a * sigm(b); }
                    u32x4 w; w.x = cvt_pk_bf16(o[0], o[1]); w.y = cvt_pk_bf16(o[2], o[3]); w.z = cvt_pk_bf16(o[4], o[5]); w.w = cvt_pk_bf16(o[6], o[7]);
                    *(u32x4*)(U + row * 512 + cj) = w;
                }
        } else {
            const int type = pn >> 1;
            bf16_t* dst = Q + (size_t)(type == 0 ? 0 : type - 1) * qvg_stride;
#pragma unroll
            for (int bj = 0; bj < 2; ++bj) {
                const int oc = (pn & 1) * 256 + bj * HALF + wc * 32 + 8 * fq, zc = type * 512 + oc;
                f32x4 bv[2], lb[2];
#pragma unroll
                for (int n = 0; n < 2; ++n) { bv[n] = *(const f32x4*)(bias + zc + 4 * n); lb[n] = *(const f32x4*)(LB + oc + 4 * n); }
#pragma unroll
                for (int ai = 0; ai < 2; ++ai)
#pragma unroll
                    for (int m = 0; m < 4; ++m) {
                        const size_t row = (size_t)(row0 + ai * HALF + m * 16);
                        float o[8];
                        if (type == 1) {
#pragma unroll
                            for (int n = 0; n < 2; ++n) { f32x4 lf;
#pragma unroll
                                for (int i = 0; i < 4; ++i) { const float v = acc[ai][bj][m][n][i] + bv[n][i]; const float f = lb[n][i] + (1.f - lb[n][i]) * sigm(v); lf[i] = __logf(f); }
                                *(f32x4*)(LF + row * 512 + oc + 4 * n) = lf; }
                        } else {
#pragma unroll
                            for (int n = 0; n < 2; ++n)
#pragma unroll
                                for (int i = 0; i < 4; ++i) { const float v = acc[ai][bj][m][n][i] + bv[n][i]; o[4 * n + i] = (type == 2) ? v : v * sigm(v); }
                            u32x4 w; w.x = cvt_pk_bf16(o[0], o[1]); w.y = cvt_pk_bf16(o[2], o[3]); w.z = cvt_pk_bf16(o[4], o[5]); w.w = cvt_pk_bf16(o[6], o[7]);
                            *(u32x4*)(dst + row * 512 + oc) = w;
                        }
                    }
            }
        }
    }
};

struct EpiRes {
    static constexpr bool PERM = false, AFTER_DRAIN = false;
    const float* xp; const float* xs; float* out; const float* bias; const float* MOD; int goff; float alpha;
    __device__ __forceinline__ void operator()(const f32x4 (&acc)[2][2][4][2], const Unit& u, int wr, int wc, int fr, int fq) const {
        const int row0 = u.pm * BM + wr * 64 + fr, col0 = u.pn * BM + wc * 32 + 4 * fq;
        f32x4 bv[2][2];
#pragma unroll
        for (int bj = 0; bj < 2; ++bj)
#pragma unroll
            for (int n = 0; n < 2; ++n) bv[bj][n] = *(const f32x4*)(bias + col0 + bj * HALF + n * 16);
#pragma unroll
        for (int ai = 0; ai < 2; ++ai)
#pragma unroll
            for (int m = 0; m < 4; ++m) {
                const int r = row0 + ai * HALF + m * 16;
                const float* xr = r < 16384 ? xp + (size_t)r * 1024 : xs + (size_t)(r - 16384) * 1024;
                const float* gr = MOD + (size_t)mod_row(r) * 6144 + goff;
                float* orow = out + (size_t)r * 1024;
#pragma unroll
                for (int bj = 0; bj < 2; ++bj)
#pragma unroll
                    for (int n = 0; n < 2; ++n) { const int c = col0 + bj * HALF + n * 16;
                        const f32x4 xv = *(const f32x4*)(xr + c), gv = *(const f32x4*)(gr + c);
                        const f32x4 o = xv * alpha + (gv + 1.f) * (acc[ai][bj][m][n] + bv[bj][n]);
                        *(f32x4*)(orow + c) = o; }
            }
    }
};

struct EpiUp {
    static constexpr bool PERM = true, AFTER_DRAIN = false;
    bf16_t* O; int ldc; const float* bias;
    __device__ __forceinline__ void operator()(const f32x4 (&acc)[2][2][4][2], const Unit& u, int wr, int wc, int fr, int fq) const {
        const int row0 = u.pm * BM + wr * 64 + fr, col0 = u.pn * BM + wc * 32 + 8 * fq;
        f32x4 bv[2][2];
#pragma unroll
        for (int bj = 0; bj < 2; ++bj)
#pragma unroll
            for (int n = 0; n < 2; ++n) bv[bj][n] = *(const f32x4*)(bias + col0 + bj * HALF + 4 * n);
#pragma unroll
        for (int ai = 0; ai < 2; ++ai)
#pragma unroll
            for (int m = 0; m < 4; ++m) { bf16_t* rowp = O + (size_t)(row0 + ai * HALF + m * 16) * ldc + col0;
#pragma unroll
                for (int bj = 0; bj < 2; ++bj) { f32x4 v0 = acc[ai][bj][m][0] + bv[bj][0], v1 = acc[ai][bj][m][1] + bv[bj][1];
#pragma unroll
                    for (int i = 0; i < 4; ++i) { const float a = fmaxf(v0[i], 0.f), b = fmaxf(v1[i], 0.f); v0[i] = a * a; v1[i] = b * b; }
                    u32x4 w; w.x = cvt_pk_bf16(v0[0], v0[1]); w.y = cvt_pk_bf16(v0[2], v0[3]); w.z = cvt_pk_bf16(v1[0], v1[1]); w.w = cvt_pk_bf16(v1[2], v1[3]);
                    *(u32x4*)(rowp + bj * HALF) = w; } }
    }
};
template <class Epi, class Sched, bool ALIGN_EPI = false, bool SP2 = false>
__device__ __forceinline__ void gemm_phase(PG8_LAS unsigned char* lds, const Gemm g, const Sched& S, const Epi& E) {
    const int tid = threadIdx.x, wid = __builtin_amdgcn_readfirstlane(tid >> 6), lane = tid & 63, wr = wid >> 2, wc = wid & 3, fr = lane & 15, fq = lane >> 4;
    const int K = g.K, nt = K / BK;
    unsigned voffA[2], voffB[2];
#pragma unroll
    for (int i = 0; i < 2; ++i) { int R, C; stage_rc(tid * 16 + i * 8192, R, C); const int Rb = Epi::PERM ? ((R & ~31) + perm32(R & 31)) : R;
        voffA[i] = (unsigned)(R * K + C) * 2u; voffB[i] = (unsigned)(Rb * K + C) * 2u; }
    const size_t kstep = (size_t)(BK * 2);
    const size_t hstep = (size_t)HALF * K * 2;
    const size_t tstep = 2 * hstep;
    const unsigned ldsw = (unsigned)wid * 1024u;
    const int aoff = lds_byte(wr * 64 + fr, fq * 8), boff = lds_byte(wc * 32 + fr, fq * 8);
#define PG8_SA(b, h) (((b) * 2 + (h)) * HTB)
#define PG8_SB(b, h) ((4 + (b) * 2 + (h)) * HTB)
#define PG8_STAGE(bufoff, gbase, voff) do { _Pragma("unroll") for (int _i = 0; _i < 2; ++_i) \
        __builtin_amdgcn_global_load_lds((const unsigned*)((const char*)(gbase) + (voff)[_i]), (PG8_LAS unsigned*)(lds + (bufoff) + ldsw + _i * 8192), 16, 0, 0); } while (0)
#define PG8_LDA(dst, b, h) do { _Pragma("unroll") for (int m = 0; m < 4; ++m) _Pragma("unroll") for (int k = 0; k < 2; ++k) dst[m][k] = *(const PG8_LAS bf16x8*)(lds + PG8_SA(b, h) + aoff + m * 2048 + k * 1024); } while (0)
#define PG8_LDB(dst, b, h) do { _Pragma("unroll") for (int n = 0; n < 2; ++n) _Pragma("unroll") for (int k = 0; k < 2; ++k) dst[n][k] = *(const PG8_LAS bf16x8*)(lds + PG8_SB(b, h) + boff + n * 2048 + k * 1024); } while (0)
#define PG8_MMA(ai, bj, At, Bt) do { __builtin_amdgcn_s_setprio(1); _Pragma("unroll") for (int m = 0; m < 4; ++m) _Pragma("unroll") for (int n = 0; n < 2; ++n) _Pragma("unroll") for (int k = 0; k < 2; ++k) \
        acc[ai][bj][m][n] = __builtin_amdgcn_mfma_f32_16x16x32_bf16(Bt[n][k], At[m][k], acc[ai][bj][m][n], 0, 0, 0); __builtin_amdgcn_s_setprio(0); } while (0)
#define PG8_WAIT_V(n) asm volatile("s_waitcnt vmcnt(" #n ")" ::: "memory")
#define PG8_WAIT_L(n) asm volatile("s_waitcnt lgkmcnt(" #n ")" ::: "memory")
#define PG8_BAR __builtin_amdgcn_s_barrier()
#define PG8_SCHED __builtin_amdgcn_sched_barrier(0)
    Unit cur, nxt; int ui = 0;
    if (!S.next(0, cur)) return;
    f32x4 acc[2][2][4][2];
#pragma unroll
    for (int a = 0; a < 2; ++a)
#pragma unroll
        for (int b = 0; b < 2; ++b)
#pragma unroll
            for (int m = 0; m < 4; ++m)
#pragma unroll
                for (int n = 0; n < 2; ++n) acc[a][b][m][n] = (f32x4){0.f, 0.f, 0.f, 0.f};
    bf16x8 At[4][2], B0[2][2], B1[2][2];
    const char* cA = (const char*)g.A + (size_t)cur.pm * tstep; const char* cB = (const char*)g.Bt + (size_t)cur.pn * tstep;
    S.a_ready(cur);
    if constexpr (SP2) {
        PG8_STAGE(PG8_SB(0, 0), cB, voffB); PG8_STAGE(PG8_SB(0, 1), cB + hstep, voffB); PG8_STAGE(PG8_SA(0, 0), cA, voffA); PG8_STAGE(PG8_SA(0, 1), cA + hstep, voffA);
        if (wr == 1) PG8_BAR;
        PG8_WAIT_V(2); PG8_BAR;
        PG8_STAGE(PG8_SB(1, 0), cB + kstep, voffB); PG8_STAGE(PG8_SA(1, 0), cA + kstep, voffA); PG8_STAGE(PG8_SB(1, 1), cB + hstep + kstep, voffB);
        PG8_WAIT_V(6); PG8_BAR;
    } else {
        PG8_STAGE(PG8_SB(0, 0), cB, voffB); PG8_STAGE(PG8_SA(0, 0), cA, voffA); PG8_STAGE(PG8_SB(0, 1), cB + hstep, voffB); PG8_STAGE(PG8_SA(0, 1), cA + hstep, voffA);
        if (wr == 1) PG8_BAR;
        PG8_WAIT_V(4); PG8_BAR;
        PG8_STAGE(PG8_SB(1, 0), cB + kstep, voffB); PG8_STAGE(PG8_SA(1, 0), cA + kstep, voffA); PG8_STAGE(PG8_SB(1, 1), cB + hstep + kstep, voffB);
        PG8_WAIT_V(6); PG8_BAR;
    }
    for (;;) {
        const bool has_next = S.next(ui + 1, nxt);
        const char* nA = has_next ? (const char*)g.A + (size_t)nxt.pm * tstep : cA; const char* nB = has_next ? (const char*)g.Bt + (size_t)nxt.pn * tstep : cB;
        for (int t = 0; t < nt; t += 2) {
            const bool last = (t == nt - 2);
            const char* a1 = cA + (size_t)(t + 1) * kstep;
            const char* a2 = last ? nA : cA + (size_t)(t + 2) * kstep; const char* b2 = last ? nB : cB + (size_t)(t + 2) * kstep;
            const char* a3 = a2 + kstep; const char* b3 = b2 + kstep;
            if (last && has_next) S.a_ready(nxt);
            if constexpr (SP2) {
            PG8_LDB(B0, 0, 0); PG8_LDB(B1, 0, 1); PG8_SCHED; PG8_LDA(At, 0, 0); PG8_STAGE(PG8_SA(1, 1), a1 + hstep, voffA);
            PG8_WAIT_V(8); PG8_WAIT_L(0); PG8_BAR; PG8_MMA(0, 0, At, B0); PG8_MMA(0, 1, At, B1); PG8_BAR; PG8_SCHED;
            PG8_LDA(At, 0, 1); PG8_STAGE(PG8_SB(0, 0), b2, voffB); PG8_STAGE(PG8_SB(0, 1), b2 + hstep, voffB); PG8_STAGE(PG8_SA(0, 0), a2, voffA);
            PG8_WAIT_V(8); PG8_WAIT_L(0); PG8_BAR; PG8_MMA(1, 0, At, B0); PG8_MMA(1, 1, At, B1); PG8_BAR; PG8_SCHED;
            PG8_LDB(B0, 1, 0); PG8_LDB(B1, 1, 1); PG8_SCHED; PG8_LDA(At, 1, 0); PG8_STAGE(PG8_SA(0, 1), a2 + hstep, voffA);
            PG8_WAIT_V(8); PG8_WAIT_L(0); PG8_BAR; PG8_MMA(0, 0, At, B0); PG8_MMA(0, 1, At, B1); PG8_BAR; PG8_SCHED;
            PG8_LDA(At, 1, 1); PG8_STAGE(PG8_SB(1, 0), b3, voffB); PG8_STAGE(PG8_SB(1, 1), b3 + hstep, voffB); PG8_STAGE(PG8_SA(1, 0), a3, voffA);
            PG8_WAIT_V(8); PG8_WAIT_L(0); PG8_BAR; PG8_MMA(1, 0, At, B0); PG8_MMA(1, 1, At, B1); PG8_BAR; PG8_SCHED;
            } else {
            PG8_LDB(B0, 0, 0); PG8_SCHED; PG8_LDA(At, 0, 0); PG8_STAGE(PG8_SA(1, 1), a1 + hstep, voffA);
            PG8_WAIT_L(8); PG8_BAR; PG8_WAIT_L(0); PG8_MMA(0, 0, At, B0); PG8_BAR; PG8_SCHED;
            PG8_LDB(B1, 0, 1); PG8_STAGE(PG8_SB(0, 0), b2, voffB);
            PG8_BAR; PG8_WAIT_L(0); PG8_MMA(0, 1, At, B1); PG8_BAR;
            PG8_LDA(At, 0, 1); PG8_STAGE(PG8_SA(0, 0), a2, voffA);
            PG8_BAR; PG8_WAIT_L(0); PG8_MMA(1, 0, At, B0); PG8_BAR; PG8_SCHED;
            PG8_STAGE(PG8_SB(0, 1), b2 + hstep, voffB);
            PG8_WAIT_V(6); PG8_BAR; PG8_MMA(1, 1, At, B1); PG8_BAR;
            PG8_LDB(B0, 1, 0); PG8_SCHED; PG8_LDA(At, 1, 0); PG8_STAGE(PG8_SA(0, 1), a2 + hstep, voffA);
            PG8_WAIT_L(8); PG8_BAR; PG8_WAIT_L(0); PG8_MMA(0, 0, At, B0); PG8_BAR; PG8_SCHED;
            PG8_LDB(B1, 1, 1); PG8_STAGE(PG8_SB(1, 0), b3, voffB);
            PG8_BAR; PG8_WAIT_L(0); PG8_MMA(0, 1, At, B1); PG8_BAR;
            PG8_LDA(At, 1, 1); PG8_STAGE(PG8_SA(1, 0), a3, voffA);
            PG8_BAR; PG8_WAIT_L(0); PG8_MMA(1, 0, At, B0); PG8_BAR; PG8_SCHED;
            PG8_STAGE(PG8_SB(1, 1), b3 + hstep, voffB);
            PG8_WAIT_V(6); PG8_BAR; PG8_MMA(1, 1, At, B1); PG8_BAR;
            }
        }
        if constexpr (ALIGN_EPI) { if (wr == 0) PG8_BAR; }
        if constexpr (!Epi::AFTER_DRAIN) { E(acc, cur, wr, wc, fr, fq); S.done(cur); }
        if (!has_next) break;
#pragma unroll
        for (int a = 0; a < 2; ++a)
#pragma unroll
            for (int b = 0; b < 2; ++b)
#pragma unroll
                for (int m = 0; m < 4; ++m)
#pragma unroll
                    for (int n = 0; n < 2; ++n) acc[a][b][m][n] = (f32x4){0.f, 0.f, 0.f, 0.f};
        cur = nxt; cA = nA; cB = nB; ++ui;
        if constexpr (ALIGN_EPI) { if (wr == 1) PG8_BAR; }
    }
    PG8_WAIT_V(0);
    if constexpr (!ALIGN_EPI) { if (wr == 0) PG8_BAR; }
    PG8_BAR;
    if constexpr (Epi::AFTER_DRAIN) { E.fused(acc, cur, wr, wc, fr, fq, lds, wid, lane); S.done(cur); }
#undef PG8_SA
#undef PG8_SB
#undef PG8_STAGE
#undef PG8_LDA
#undef PG8_LDB
#undef PG8_MMA
#undef PG8_WAIT_V
#undef PG8_WAIT_L
#undef PG8_BAR
#undef PG8_SCHED
}
}

constexpr int NWAVES = 8, NT = NWAVES * 64;
constexpr int MP = 16384, MS = 512, M = MP + MS, D = 1024, NIN = 3072, FF = 4096, HW = 512, SEQ = 2048;
constexpr float LN_EPS = 1e-5f;
constexpr float ALPHA = 1.189207115002721f;
constexpr size_t MiB = 1u << 20;
constexpr size_t WS_WIN = 0, WS_WOUT = 6 * MiB, WS_WUP = 8 * MiB, WS_WDN = 16 * MiB, WS_MOD = 24 * MiB, WS_LB = 28 * MiB, WS_H = 29 * MiB;
constexpr size_t WS_Q = 62 * MiB, WS_V = WS_Q + (size_t)M * HW * 2, WS_G = WS_V + (size_t)M * HW * 2, WS_U = WS_G + (size_t)M * HW * 2, WS_LF = WS_U + (size_t)M * HW * 2;
constexpr size_t WS_MIX = WS_LF + (size_t)M * HW * 4, WS_HB = 62 * MiB, WS_END = WS_HB + (size_t)M * FF * 2;
static_assert(WS_MIX + (size_t)M * D * 2 == WS_END && WS_END <= 256 * MiB && WS_H + (size_t)M * D * 2 <= WS_Q, "d_ws map");
constexpr int LDS_BYTES = 147456;

#define LAS __attribute__((address_space(3)))
typedef unsigned short bf16;
typedef short bf16x8 __attribute__((ext_vector_type(8)));
typedef float f32x4 __attribute__((ext_vector_type(4)));
typedef float f32x16 __attribute__((ext_vector_type(16)));
typedef unsigned u32x4 __attribute__((ext_vector_type(4)));
typedef unsigned u32x2 __attribute__((ext_vector_type(2)));
#define DI __device__ __forceinline__
#define MFMA32(a, b, c) __builtin_amdgcn_mfma_f32_32x32x16_bf16((a), (b), (c), 0, 0, 0)
DI float bf2f(unsigned short b) { return __uint_as_float((unsigned)b << 16); }
DI unsigned f2bf(float f) { unsigned u = __float_as_uint(f); return (u + 0x7fffu + ((u >> 16) & 1u)) >> 16; }
DI unsigned pk2(float lo, float hi) { return f2bf(lo) | (f2bf(hi) << 16); }
DI float sigm(float x) { return __builtin_amdgcn_rcpf(1.f + __expf(-x)); }
DI int crow(int reg, int h) { return (reg & 3) + 8 * (reg >> 2) + 4 * h; }
DI int mod_row(int r) { return r < MP ? (r >> 11) : 8 + ((r - MP) >> 2); }
DI float wave_sum(float v) {
#pragma unroll
    for (int o = 1; o < 64; o <<= 1) v += __shfl_xor(v, o);
    return v;
}
DI f32x16 zero16() { f32x16 z;
#pragma unroll
    for (int i = 0; i < 16; ++i) z[i] = 0.f;
    return z; }

DI void p0_transpose_item(const float* W, int K, int N, bf16* WT, int k0, int n0, int drow0, LAS float* scr, int lane) {
#pragma unroll 8
    for (int i = 0; i < 32; ++i) { const int kk = 2 * i + (lane >> 5); scr[kk * 33 + (lane & 31)] = W[(size_t)(k0 + kk) * N + n0 + (lane & 31)]; }
    asm volatile("s_waitcnt lgkmcnt(0)" ::: "memory");
    const int c = lane & 7;
#pragma unroll
    for (int j = 0; j < 4; ++j) { const int n = (lane >> 3) + 8 * j; const LAS float* s = scr + (8 * c) * 33 + n;
        u32x4 o; o.x = pk2(s[0 * 33], s[1 * 33]); o.y = pk2(s[2 * 33], s[3 * 33]); o.z = pk2(s[4 * 33], s[5 * 33]); o.w = pk2(s[6 * 33], s[7 * 33]);
        *(u32x4*)(WT + (size_t)(drow0 + n) * K + k0 + 8 * c) = o; }
    asm volatile("s_waitcnt lgkmcnt(0)" ::: "memory");
}
DI int win_dest_row(int n) {
    if (n < 2048) return n;
    if (n < 2560) { const int jj = n - 2048; return 2048 + 256 * (jj >> 7) + (jj & 127); }
    const int jj = n - 2560; return 2048 + 256 * (jj >> 7) + 128 + (jj & 127);
}
DI void p0_mod(LAS unsigned char* lds, const float* cp, const float* cs, const float* w_ada, const float* b_ada, float* MOD, int G) {
    const int tid = threadIdx.x, lane = tid & 63, w = __builtin_amdgcn_readfirstlane(tid >> 6), r = lane & 31, hh = lane >> 5;
    LAS float* red = (LAS float*)lds;
    for (int nt = blockIdx.x; nt < 192; nt += G) {
        const int n0 = nt * 32, kb = w * 128;
        bf16x8 Bf[8];
#pragma unroll
        for (int ks = 0; ks < 8; ++ks) {
            float t[8];
#pragma unroll
            for (int j = 0; j < 8; ++j) t[j] = w_ada[(size_t)(kb + 16 * ks + 8 * hh + j) * 6144 + n0 + r];
            u32x4 p; p.x = pk2(t[0], t[1]); p.y = pk2(t[2], t[3]); p.z = pk2(t[4], t[5]); p.w = pk2(t[6], t[7]);
            Bf[ks] = __builtin_bit_cast(bf16x8, p);
        }
        for (int mt = 0; mt < 5; ++mt) {
            const int row = 32 * mt + r, rc = row < 136 ? row : 135;
            const float* crow_ = rc < 8 ? cp + (size_t)rc * 1024 : cs + (size_t)(rc - 8) * 1024;
            f32x16 acc = zero16();
#pragma unroll
            for (int ks = 0; ks < 8; ++ks) {
                const f32x4 a0 = *(const f32x4*)(crow_ + kb + 16 * ks + 8 * hh), a1 = *(const f32x4*)(crow_ + kb + 16 * ks + 8 * hh + 4);
                u32x4 p; p.x = pk2(a0[0] * sigm(a0[0]), a0[1] * sigm(a0[1])); p.y = pk2(a0[2] * sigm(a0[2]), a0[3] * sigm(a0[3]));
                p.z = pk2(a1[0] * sigm(a1[0]), a1[1] * sigm(a1[1])); p.w = pk2(a1[2] * sigm(a1[2]), a1[3] * sigm(a1[3]));
                acc = MFMA32(__builtin_bit_cast(bf16x8, p), Bf[ks], acc);
            }
#pragma unroll
            for (int reg = 0; reg < 16; ++reg) red[(w * 16 + reg) * 64 + lane] = acc[reg];
            __syncthreads();
#pragma unroll
            for (int i = 0; i < 2; ++i) {
                const int o = tid + 512 * i, reg = o >> 6, ln = o & 63;
                float s = 0.f;
#pragma unroll
                for (int ww = 0; ww < 8; ++ww) s += red[(ww * 16 + reg) * 64 + ln];
                const int rowo = 32 * mt + crow(reg, ln >> 5), col = n0 + (ln & 31);
                if (rowo < 136) MOD[(size_t)rowo * 6144 + col] = s + b_ada[col];
            }
            __syncthreads();
        }
    }
}

constexpr int HQ_QE = 0, HQ_KE = 17408, HQ_KDT = 34816, HQ_VT = 53248, HQ_ATT = 71680, HQ_ST = 80896, HQ_SEG = 115712, HQ_EBL = 117760;
DI void hgrn_prompt_unit(LAS unsigned char* lds, int b, int h, const bf16* Q, const float* LF, const bf16* V, const bf16* Gt, const float* hgw, bf16* MIX, float* Sout) {
    const int tid = threadIdx.x, lane = tid & 63, w = __builtin_amdgcn_readfirstlane(tid >> 6), r = lane & 31, hh = lane >> 5;
    LAS bf16* QE = (LAS bf16*)(lds + HQ_QE); LAS bf16* KE = (LAS bf16*)(lds + HQ_KE); LAS float* OST = (LAS float*)(lds + HQ_QE);
    LAS bf16* KDT = (LAS bf16*)(lds + HQ_KDT); LAS bf16* VT = (LAS bf16*)(lds + HQ_VT); LAS bf16* ATT = (LAS bf16*)(lds + HQ_ATT); LAS bf16* ST = (LAS bf16*)(lds + HQ_ST);
    LAS float* SEG = (LAS float*)(lds + HQ_SEG); LAS float* EBL = (LAS float*)(lds + HQ_EBL);
    for (int i = tid; i < 34816 / 16; i += NT) ((LAS u32x4*)(lds + HQ_ST))[i] = (u32x4){0u, 0u, 0u, 0u};
    f32x16 accS[2]; accS[0] = zero16(); accS[1] = zero16();
    const int k = tid & 127, seg = __builtin_amdgcn_readfirstlane(tid >> 7);
    const int vt = w & 3, tt = w >> 2, ktb = 2 * (w >> 2);
    __syncthreads();
    for (int c = 0; c < SEQ / 64; ++c) {
        const size_t rowb = (size_t)b * SEQ + c * 64 + seg * 16, cb = (size_t)h * 128 + k;
        float lf[16], qv[16]; unsigned vr[16];
#pragma unroll
        for (int i = 0; i < 16; ++i) { const size_t off = (rowb + i) * HW + cb; lf[i] = LF[off]; qv[i] = bf2f(Q[off]); vr[i] = V[off]; }
        float ssum = 0.f;
#pragma unroll
        for (int i = 0; i < 16; ++i) ssum += lf[i];
        SEG[seg * 128 + k] = ssum;
        __syncthreads();
        const float s0 = SEG[k], s1 = SEG[128 + k], s2 = SEG[256 + k], s3 = SEG[384 + k];
        const float bl = (s0 + s1) + (s2 + s3);
        float bcur = seg == 0 ? 0.f : (seg == 1 ? s0 : (seg == 2 ? s0 + s1 : (s0 + s1) + s2));
        if (seg == 0) EBL[k] = __expf(bl);
        unsigned kdp[8], vp[8];
#pragma unroll
        for (int i = 0; i < 16; ++i) {
            bcur += lf[i];
            const float eb = __expf(bcur), enb = __expf(-bcur), kk = 1.f - __expf(lf[i]);
            const float qe = qv[i] * eb, ke = kk * enb, kd = kk * __expf(bl - bcur);
            const int t = seg * 16 + i;
            QE[t * 136 + k] = (bf16)f2bf(qe); KE[t * 136 + k] = (bf16)f2bf(ke);
            if (i & 1) { kdp[i >> 1] |= f2bf(kd) << 16; vp[i >> 1] |= vr[i] << 16; } else { kdp[i >> 1] = f2bf(kd); vp[i >> 1] = vr[i]; }
        }
        *(LAS u32x4*)(KDT + k * 72 + seg * 16) = (u32x4){kdp[0], kdp[1], kdp[2], kdp[3]}; *(LAS u32x4*)(KDT + k * 72 + seg * 16 + 8) = (u32x4){kdp[4], kdp[5], kdp[6], kdp[7]};
        *(LAS u32x4*)(VT + k * 72 + seg * 16) = (u32x4){vp[0], vp[1], vp[2], vp[3]}; *(LAS u32x4*)(VT + k * 72 + seg * 16 + 8) = (u32x4){vp[4], vp[5], vp[6], vp[7]};
        __syncthreads();
        f32x16 acco = zero16();
#pragma unroll
        for (int ks = 0; ks < 8; ++ks) {
            const bf16x8 a = *(const LAS bf16x8*)(QE + (32 * tt + r) * 136 + 16 * ks + 8 * hh), bb = *(const LAS bf16x8*)(ST + (32 * vt + r) * 136 + 16 * ks + 8 * hh);
            acco = MFMA32(a, bb, acco);
        }
        if (w < 3) {
            const int at = (w >= 1) ? 1 : 0, as = (w == 2) ? 1 : 0;
            f32x16 acca = zero16();
#pragma unroll
            for (int ks = 0; ks < 8; ++ks) {
                const bf16x8 a = *(const LAS bf16x8*)(QE + (32 * at + r) * 136 + 16 * ks + 8 * hh), bb = *(const LAS bf16x8*)(KE + (32 * as + r) * 136 + 16 * ks + 8 * hh);
                acca = MFMA32(a, bb, acca);
            }
#pragma unroll
            for (int reg = 0; reg < 16; ++reg) { const int tr = crow(reg, hh); float v = acca[reg]; if (at == as && tr < r) v = 0.f; ATT[(32 * at + tr) * 72 + 32 * as + r] = (bf16)f2bf(v); }
        } else if (w == 3) {
#pragma unroll
            for (int reg = 0; reg < 16; ++reg) ATT[crow(reg, hh) * 72 + 32 + r] = (bf16)0;
        }
        __syncthreads();
#pragma unroll
        for (int ks = 0; ks < 4; ++ks) {
            const bf16x8 a = *(const LAS bf16x8*)(ATT + (32 * tt + r) * 72 + 16 * ks + 8 * hh), bb = *(const LAS bf16x8*)(VT + (32 * vt + r) * 72 + 16 * ks + 8 * hh);
            acco = MFMA32(a, bb, acco);
        }
#pragma unroll
        for (int reg = 0; reg < 16; ++reg) OST[(32 * tt + crow(reg, hh)) * 132 + 32 * vt + r] = acco[reg];
#pragma unroll
        for (int j = 0; j < 2; ++j) {
            const int kt = ktb + j; const float e = EBL[32 * kt + r];
#pragma unroll
            for (int reg = 0; reg < 16; ++reg) accS[j][reg] *= e;
#pragma unroll
            for (int ks = 0; ks < 4; ++ks) {
                const bf16x8 a = *(const LAS bf16x8*)(VT + (32 * vt + r) * 72 + 16 * ks + 8 * hh), bb = *(const LAS bf16x8*)(KDT + (32 * kt + r) * 72 + 16 * ks + 8 * hh);
                accS[j] = MFMA32(a, bb, accS[j]);
            }
#pragma unroll
            for (int reg = 0; reg < 16; ++reg) ST[(32 * vt + crow(reg, hh)) * 136 + 32 * kt + r] = (bf16)f2bf(accS[j][reg]);
        }
        __syncthreads();
        {
            const int t = tid >> 3, part = tid & 7; const size_t row = (size_t)b * SEQ + c * 64 + t;
            f32x4 o[4]; float ssq = 0.f;
#pragma unroll
            for (int j = 0; j < 4; ++j) { o[j] = *(const LAS f32x4*)(OST + t * 132 + 16 * part + 4 * j); ssq += (o[j][0] * o[j][0] + o[j][1] * o[j][1]) + (o[j][2] * o[j][2] + o[j][3] * o[j][3]); }
            ssq += __shfl_xor(ssq, 1); ssq += __shfl_xor(ssq, 2); ssq += __shfl_xor(ssq, 4);
            const float rs = rsqrtf(ssq * (1.f / 128.f) + LN_EPS);
            const u32x4 g0 = *(const u32x4*)(Gt + row * HW + h * 128 + 16 * part), g1 = *(const u32x4*)(Gt + row * HW + h * 128 + 16 * part + 8);
            const unsigned gw_[8] = {g0.x, g0.y, g0.z, g0.w, g1.x, g1.y, g1.z, g1.w};
            unsigned ow[8];
#pragma unroll
            for (int j = 0; j < 4; ++j) {
                const f32x4 wv = *(const f32x4*)(hgw + 16 * part + 4 * j);
                const float a0 = o[j][0] * rs * wv[0] * bf2f((unsigned short)(gw_[2 * j] & 0xffffu)), a1 = o[j][1] * rs * wv[1] * bf2f((unsigned short)(gw_[2 * j] >> 16));
                const float a2 = o[j][2] * rs * wv[2] * bf2f((unsigned short)(gw_[2 * j + 1] & 0xffffu)), a3 = o[j][3] * rs * wv[3] * bf2f((unsigned short)(gw_[2 * j + 1] >> 16));
                ow[2 * j] = pk2(a0, a1); ow[2 * j + 1] = pk2(a2, a3);
            }
            *(u32x4*)(MIX + row * D + h * 128 + 16 * part) = (u32x4){ow[0], ow[1], ow[2], ow[3]}; *(u32x4*)(MIX + row * D + h * 128 + 16 * part + 8) = (u32x4){ow[4], ow[5], ow[6], ow[7]};
        }
        __syncthreads();
    }
#pragma unroll
    for (int j = 0; j < 2; ++j) { const int kt = ktb + j; float* dst = Sout + ((size_t)(b * 4 + h) * 128 + 32 * kt + r) * 128 + 32 * vt + 4 * hh;
#pragma unroll
        for (int g4 = 0; g4 < 4; ++g4) *(f32x4*)(dst + 8 * g4) = (f32x4){accS[j][4 * g4], accS[j][4 * g4 + 1], accS[j][4 * g4 + 2], accS[j][4 * g4 + 3]}; }
}

DI void hgrn_sample_unit(LAS unsigned char* lds, int b, int h, const bf16* Q, const float* LF, const bf16* V, const bf16* Gt, const float* hgw, const float* S0, bf16* MIX, float* Sout) {
    const int tid = threadIdx.x, lane = tid & 63, w = __builtin_amdgcn_readfirstlane(tid >> 6);
    LAS float* qeS = (LAS float*)lds; LAS float* keS = qeS + 512; LAS float* kdS = qeS + 1024; LAS float* vS = qeS + 1536; LAS float* eblS = qeS + 2048;
    LAS float* attS = qeS + 2176; LAS float* opart = qeS + 2240; LAS float* ssqS = qeS + 2240 + 2048;
    const size_t row0 = (size_t)MP + 4 * b;
    if (tid < 128) {
        const int k = tid; float lfv[4], qq[4];
#pragma unroll
        for (int t = 0; t < 4; ++t) { const size_t off = (row0 + t) * HW + h * 128 + k; lfv[t] = LF[off]; qq[t] = bf2f(Q[off]); }
        const float bl = (lfv[0] + lfv[1]) + (lfv[2] + lfv[3]); float bc = 0.f;
#pragma unroll
        for (int t = 0; t < 4; ++t) { bc += lfv[t]; const float kk = 1.f - __expf(lfv[t]);
            qeS[t * 128 + k] = qq[t] * __expf(bc); keS[t * 128 + k] = kk * __expf(-bc); kdS[t * 128 + k] = kk * __expf(bl - bc); }
        eblS[k] = __expf(bl);
    } else if (tid < 256) {
        const int v = tid - 128;
#pragma unroll
        for (int t = 0; t < 4; ++t) vS[t * 128 + v] = bf2f(V[(row0 + t) * HW + h * 128 + v]);
    }
    __syncthreads();
    if (w < 4) {
        const int t = w;
        for (int s = 0; s <= t; ++s) {
            float p = qeS[t * 128 + lane] * keS[s * 128 + lane] + qeS[t * 128 + 64 + lane] * keS[s * 128 + 64 + lane];
            p = wave_sum(p);
            if (lane == 0) attS[t * 4 + s] = p;
        }
    }
    {
        const int v = tid & 127, kq = tid >> 7;
        float op[4] = {0.f, 0.f, 0.f, 0.f};
        const float* S0p = S0 + ((size_t)(b * 4 + h) * 128 + 32 * kq) * 128 + v; float* Snp = Sout + ((size_t)(b * 4 + h) * 128 + 32 * kq) * 128 + v;
        const float v0 = vS[v], v1 = vS[128 + v], v2 = vS[256 + v], v3 = vS[384 + v];
#pragma unroll 8
        for (int kk = 0; kk < 32; ++kk) {
            const int k = 32 * kq + kk; const float s0 = S0p[kk * 128];
            op[0] += qeS[k] * s0; op[1] += qeS[128 + k] * s0; op[2] += qeS[256 + k] * s0; op[3] += qeS[384 + k] * s0;
            Snp[kk * 128] = eblS[k] * s0 + ((kdS[k] * v0 + kdS[128 + k] * v1) + (kdS[256 + k] * v2 + kdS[384 + k] * v3));
        }
#pragma unroll
        for (int t = 0; t < 4; ++t) opart[(kq * 4 + t) * 128 + v] = op[t];
    }
    __syncthreads();
    {
        const int t = tid >> 7, v = tid & 127;
        float o = (opart[t * 128 + v] + opart[(4 + t) * 128 + v]) + (opart[(8 + t) * 128 + v] + opart[(12 + t) * 128 + v]);
        for (int s = 0; s <= t; ++s) o += attS[t * 4 + s] * vS[s * 128 + v];
        const float q = wave_sum(o * o);
        if (lane == 0) ssqS[w] = q;
        __syncthreads();
        const float rs = rsqrtf((ssqS[2 * t] + ssqS[2 * t + 1]) * (1.f / 128.f) + LN_EPS);
        const float res = o * rs * hgw[v] * bf2f(Gt[(row0 + t) * HW + h * 128 + v]);
        MIX[(row0 + t) * D + h * 128 + v] = (bf16)f2bf(res);
    }
    __syncthreads();
}

DI float conv_post(float acc, float gg, float gb) {
    const float mean = wave_sum(acc) * (1.f / 64.f), d = acc - mean;
    const float var = wave_sum(d * d) * (1.f / 64.f);
    const float y = d * rsqrtf(var + LN_EPS) * gg + gb;
    return y * sigm(y);
}
DI void conv_prompt_unit(int b, int tb, const bf16* U, const float (&cw)[31], float cbias, float gg, float gb, bf16* MIX, float* NCP) {
    const int c = threadIdx.x, t0 = 8 * tb;
    float win[38];
#pragma unroll
    for (int j = 0; j < 38; ++j) { const int tok = t0 - 30 + j, tc = tok < 0 ? 0 : tok; const float v = bf2f(U[((size_t)b * SEQ + tc) * HW + c]); win[j] = tok < 0 ? 0.f : v; }
#pragma unroll
    for (int i = 0; i < 8; ++i) {
        float acc = cbias;
#pragma unroll
        for (int j = 0; j < 31; ++j) acc += cw[j] * win[i + j];
        const float o = conv_post(acc, gg, gb);
        MIX[((size_t)b * SEQ + t0 + i) * D + 512 + c] = (bf16)f2bf(o);
        if (t0 + i >= SEQ - 30) NCP[((size_t)b * 30 + (t0 + i - (SEQ - 30))) * HW + c] = win[30 + i];
    }
}
DI void conv_sample_unit(int b, const bf16* U, const float* sconv, const float (&cw)[31], float cbias, float gg, float gb, bf16* MIX, float* NCS) {
    const int c = threadIdx.x;
    float full[34];
#pragma unroll
    for (int j = 0; j < 30; ++j) full[j] = sconv[((size_t)b * 30 + j) * HW + c];
#pragma unroll
    for (int t = 0; t < 4; ++t) full[30 + t] = bf2f(U[((size_t)MP + 4 * b + t) * HW + c]);
#pragma unroll
    for (int t = 0; t < 4; ++t) {
        float acc = cbias;
#pragma unroll
        for (int j = 0; j < 31; ++j) acc += cw[j] * full[t + j];
        const float o = conv_post(acc, gg, gb);
        MIX[((size_t)MP + 4 * b + t) * D + 512 + c] = (bf16)f2bf(o);
    }
#pragma unroll
    for (int j = 0; j < 30; ++j) NCS[((size_t)b * 30 + j) * HW + c] = full[4 + j];
}

template <bool WITH_H>
DI void ln_rows(float* io, const float* g, const float* bta, const float* MOD, int shoff, bf16* H, int gw, int ngw, int lane) {
    for (int m = gw; m < M; m += ngw) {
        float* row = io + (size_t)m * D;
        f32x4 v[4]; float s = 0.f;
#pragma unroll
        for (int j = 0; j < 4; ++j) { v[j] = *(const f32x4*)(row + 4 * lane + 256 * j); s += (v[j][0] + v[j][1]) + (v[j][2] + v[j][3]); }
        const float mean = wave_sum(s) * (1.f / D); float s2 = 0.f;
#pragma unroll
        for (int j = 0; j < 4; ++j) { v[j] = v[j] - mean; s2 += (v[j][0] * v[j][0] + v[j][1] * v[j][1]) + (v[j][2] * v[j][2] + v[j][3] * v[j][3]); }
        const float rstd = rsqrtf(wave_sum(s2) * (1.f / D) + LN_EPS);
        const float* mr = MOD + (size_t)mod_row(m) * 6144 + shoff;
#pragma unroll
        for (int j = 0; j < 4; ++j) {
            const int col = 4 * lane + 256 * j;
            const f32x4 gv = *(const f32x4*)(g + col), bv = *(const f32x4*)(bta + col);
            const f32x4 x1 = v[j] * rstd * gv + bv;
            *(f32x4*)(row + col) = x1;
            if (WITH_H) { const f32x4 sh = *(const f32x4*)(mr + col), sc = *(const f32x4*)(mr + 1024 + col); const f32x4 hv = x1 * (sc + 1.f) + sh;
                *(u32x2*)(H + (size_t)m * D + col) = (u32x2){pk2(hv[0], hv[1]), pk2(hv[2], hv[3])}; }
        }
    }
}

struct Args { const float* in[26]; float* out; unsigned char* ws; int ph_lo, ph_hi; };
enum { I_XP = 0, I_XS, I_CP, I_CS, I_SH, I_SC, I_LB, I_WIN, I_BIN, I_HGW, I_CW, I_CB, I_GNG, I_GNB, I_WOUT, I_BOUT, I_LN1G, I_LN1B, I_WUP, I_BUP, I_WDN, I_BDN, I_LN2G, I_LN2B, I_WADA, I_BADA };
constexpr int N_PHASES = 9;

__global__ void __launch_bounds__(NT, 2) fwd_kernel(Args args) {
    extern __shared__ __attribute__((aligned(16))) unsigned char lds_raw[];
    LAS unsigned char* lds = (LAS unsigned char*)lds_raw;
    const int tid = threadIdx.x, lane = tid & 63, wave = __builtin_amdgcn_readfirstlane(tid >> 6);
    const int G = gridDim.x, bx = blockIdx.x;
    const int gw = bx * NWAVES + wave, ngw = G * NWAVES;
    unsigned char* ws = args.ws;
    const float* xp = args.in[I_XP]; const float* xs = args.in[I_XS];
    float* out = args.out;
    float* y = out;
    float* NHP = out + (size_t)M * D;
    float* NCP = NHP + (size_t)8 * 4 * 128 * 128;
    float* NHS = NCP + (size_t)8 * 30 * 512;
    float* NCS = NHS + (size_t)128 * 4 * 128 * 128;
    bf16* WTin = (bf16*)(ws + WS_WIN); bf16* WTout = (bf16*)(ws + WS_WOUT); bf16* WTup = (bf16*)(ws + WS_WUP); bf16* WTdn = (bf16*)(ws + WS_WDN);
    float* MOD = (float*)(ws + WS_MOD); float* LBv = (float*)(ws + WS_LB);
    bf16* Hb = (bf16*)(ws + WS_H); bf16* Qb = (bf16*)(ws + WS_Q); bf16* Vb = (bf16*)(ws + WS_V); bf16* Gb = (bf16*)(ws + WS_G); bf16* Ub = (bf16*)(ws + WS_U);
    float* LFb = (float*)(ws + WS_LF); bf16* MIX = (bf16*)(ws + WS_MIX); bf16* HB = (bf16*)(ws + WS_HB);
    const int lo = args.ph_lo, hi = args.ph_hi;
#define IN(k) (lo <= (k) && (k) < hi)
#define SEAM(k) do { if (IN(k) && IN((k) + 1)) { cg::this_grid().sync(); } } while (0)

    if (IN(0)) {
        p0_mod(lds, args.in[I_CP], args.in[I_CS], args.in[I_WADA], args.in[I_BADA], MOD, G);
        __syncthreads();
        LAS float* scr = (LAS float*)(lds + wave * 16384);
        constexpr int IT_IN = 16 * 96, IT_OUT = 16 * 32, IT_UP = 16 * 128, IT_DN = 64 * 32, NITEMS = IT_IN + IT_OUT + IT_UP + IT_DN;
        for (int it = gw; it < NITEMS; it += ngw) {
            int q = it;
            if (q < IT_IN) { const int kb = q / 96, nb = q % 96; p0_transpose_item(args.in[I_WIN], D, NIN, WTin, 64 * kb, 32 * nb, win_dest_row(32 * nb), scr, lane); continue; } q -= IT_IN;
            if (q < IT_OUT) { const int kb = q / 32, nb = q % 32; p0_transpose_item(args.in[I_WOUT], D, D, WTout, 64 * kb, 32 * nb, 32 * nb, scr, lane); continue; } q -= IT_OUT;
            if (q < IT_UP) { const int kb = q / 128, nb = q % 128; p0_transpose_item(args.in[I_WUP], D, FF, WTup, 64 * kb, 32 * nb, 32 * nb, scr, lane); continue; } q -= IT_UP;
            { const int kb = q / 32, nb = q % 32; p0_transpose_item(args.in[I_WDN], FF, D, WTdn, 64 * kb, 32 * nb, 32 * nb, scr, lane); }
        }
        const int gt = bx * NT + tid;
        if (gt < HW) { const float* l = args.in[I_LB]; LBv[gt] = 1.f / (1.f + __expf(l[HW + gt] - l[gt])); }
    }
    SEAM(0);
    if (IN(1)) {
        for (int m = gw; m < M; m += ngw) {
            const float* xr = m < MP ? xp + (size_t)m * D : xs + (size_t)(m - MP) * D;
            const float* mr = MOD + (size_t)mod_row(m) * 6144;
#pragma unroll
            for (int j = 0; j < 4; ++j) { const int col = 4 * lane + 256 * j;
                const f32x4 xv = *(const f32x4*)(xr + col), sh = *(const f32x4*)(mr + col), sc = *(const f32x4*)(mr + 1024 + col);
                const f32x4 hv = xv * (sc + 1.f) + sh;
                *(u32x2*)(Hb + (size_t)m * D + col) = (u32x2){pk2(hv[0], hv[1]), pk2(hv[2], hv[3])}; }
        }
    }
    SEAM(1);
    if (IN(2)) {
        pg8::Gemm g{Hb, WTin, M, NIN, D}; pg8::StaticOrder S; S.init(M, NIN, G, bx);
        pg8::EpiIn E{Qb, Ub, (size_t)M * HW, LFb, args.in[I_BIN], LBv};
        pg8::gemm_phase<pg8::EpiIn, pg8::StaticOrder, true, true>(lds, g, S, E);
    }
    SEAM(2);
    if (IN(3)) {
        const bool split = (G >= 64);
        if (!split || bx < 32) {
            for (int u = bx; u < 32; u += (split ? 32 : G)) hgrn_prompt_unit(lds, u >> 2, u & 3, Qb, LFb, Vb, Gb, args.in[I_HGW], MIX, NHP);
        }
        if (!split || bx >= 32) {
            const int pid = split ? bx - 32 : bx, pnum = split ? G - 32 : G;
            float cw[31];
#pragma unroll
            for (int j = 0; j < 31; ++j) cw[j] = args.in[I_CW][j * HW + tid];
            const float cbias = args.in[I_CB][tid], gg = args.in[I_GNG][tid], gb = args.in[I_GNB][tid];
            for (int u = pid; u < 2048; u += pnum) conv_prompt_unit(u >> 8, u & 255, Ub, cw, cbias, gg, gb, MIX, NCP);
            for (int u = pid; u < 128; u += pnum) conv_sample_unit(u, Ub, args.in[I_SC], cw, cbias, gg, gb, MIX, NCS);
            asm volatile("" ::: "memory");
            for (int q = pid; q < 512; q += pnum) hgrn_sample_unit(lds, q >> 2, q & 3, Qb, LFb, Vb, Gb, args.in[I_HGW], args.in[I_SH], MIX, NHS);
        }
    }
    SEAM(3);
    if (IN(4)) {
        pg8::Gemm g{MIX, WTout, M, D, D}; pg8::StaticOrder S; S.init(M, D, G, bx);
        pg8::EpiRes E{xp, xs, y, args.in[I_BOUT], MOD, 2048, ALPHA};
        pg8::gemm_phase<pg8::EpiRes, pg8::StaticOrder, true, true>(lds, g, S, E);
    }
    SEAM(4);
    if (IN(5)) ln_rows<true>(y, args.in[I_LN1G], args.in[I_LN1B], MOD, 3072, Hb, gw, ngw, lane);
    SEAM(5);
    if (IN(6)) {
        pg8::Gemm g{Hb, WTup, M, FF, D}; pg8::StaticOrder S; S.init(M, FF, G, bx);
        pg8::EpiUp E{HB, FF, args.in[I_BUP]};
        pg8::gemm_phase<pg8::EpiUp, pg8::StaticOrder, true, true>(lds, g, S, E);
    }
    SEAM(6);
    if (IN(7)) {
        pg8::Gemm g{HB, WTdn, M, D, FF}; pg8::StaticOrder S; S.init(M, D, G, bx);
        pg8::EpiRes E{y, y + (size_t)MP * D, y, args.in[I_BDN], MOD, 5120, ALPHA};
        pg8::gemm_phase<pg8::EpiRes, pg8::StaticOrder, true, true>(lds, g, S, E);
    }
    SEAM(7);
    if (IN(8)) ln_rows<false>(y, args.in[I_LN2G], args.in[I_LN2B], MOD, 0, nullptr, gw, ngw, lane);
#undef IN
#undef SEAM
}

#ifndef N_LAUNCH_MODE
#define N_LAUNCH_MODE 1
#endif
extern "C" void kernel_launch(void* const* d_in, const int* in_sizes, int n_in, void* d_out, int out_size, void* d_ws, size_t ws_size, hipStream_t stream) {
    static int grid = 0;
    if (grid == 0) {
        int dev = 0, cus = 0, per_cu = 0;
        if (n_in != 26 || ws_size < WS_END) { fprintf(stderr, "kernel_launch: unexpected n_in %d / ws %zu\n", n_in, ws_size); grid = -1; return; }
        if (hipGetDevice(&dev) != hipSuccess || hipDeviceGetAttribute(&cus, hipDeviceAttributeMultiprocessorCount, dev) != hipSuccess) { grid = -1; return; }
        if (hipFuncSetAttribute((const void*)fwd_kernel, hipFuncAttributeMaxDynamicSharedMemorySize, LDS_BYTES) != hipSuccess) { fprintf(stderr, "kernel_launch: hipFuncSetAttribute failed\n"); grid = -1; return; }
        if (hipOccupancyMaxActiveBlocksPerMultiprocessor(&per_cu, (const void*)fwd_kernel, NT, LDS_BYTES) != hipSuccess || per_cu < 1) per_cu = 1;
        (void)hipGetLastError();
        grid = cus * 1;
    }
    if (grid < 0) return;
    Args a{};
    for (int i = 0; i < 26; ++i) a.in[i] = (const float*)d_in[i];
    a.out = (float*)d_out; a.ws = (unsigned char*)d_ws;
#if N_LAUNCH_MODE == 1
    a.ph_lo = 0; a.ph_hi = N_PHASES;
    void* kargs[] = {&a};
    hipError_t e = hipLaunchCooperativeKernel((const void*)fwd_kernel, dim3(grid), dim3(NT), kargs, LDS_BYTES, stream);
    if (e != hipSuccess) fprintf(stderr, "cooperative launch failed: %s (grid %d)\n", hipGetErrorString(e), grid);
#else
    for (int p = 0; p < N_PHASES; ++p) { a.ph_lo = p; a.ph_hi = p + 1; hipLaunchKernelGGL(fwd_kernel, dim3(grid), dim3(NT), LDS_BYTES, stream, a); }
#endif
}
```

```cpp
#include <hip/hip_runtime.h>
#include <hip/hip_cooperative_groups.h>
#include <cstdio>
#include <cstdint>
namespace cg = cooperative_groups;
namespace pg8 {
#define PG8_LAS __attribute__((address_space(3)))
typedef unsigned short bf16_t;
typedef short bf16x8 __attribute__((ext_vector_type(8)));
typedef float f32x4 __attribute__((ext_vector_type(4)));
typedef unsigned u32x4 __attribute__((ext_vector_type(4)));
constexpr int BM = 256, BK = 64, HALF = 128, HTB = HALF * BK * 2  , STAGE_BYTES = 8 * HTB, NXCD = 8, WGM = 8;

__host__ __device__ __forceinline__ int lds_byte(int r, int c) { const int st = (r >> 4) * 2 + (c >> 5), rr = r & 15, cc = c & 31, ob = rr * 64 + cc * 2; return st * 1024 + (ob ^ (((ob >> 9) & 1) << 5)); }
__host__ __device__ __forceinline__ void stage_rc(int b, int& R, int& C) { const int st = b / 1024, sb = b % 1024, swz = sb ^ (((sb >> 9) & 1) << 5); R = (st >> 1) * 16 + swz / 64; C = (st & 1) * 32 + (swz % 64) / 2; }
__host__ __device__ __forceinline__ int perm32(int rho) { const int n = rho >> 4, i = rho & 15; return 8 * (i >> 2) + 4 * n + (i & 3); }

struct Unit { int pm, pn; };
struct Gemm { const bf16_t* A; const bf16_t* Bt; int M, N, K; };

struct StaticOrder {
    int nM, nN, nwg, G, c;
    __host__ __device__ void init(int M, int N, int G_, int c_) { nM = M / BM; nN = N / BM; nwg = nM * nN; G = G_; c = c_; }
    __host__ __device__ bool next(int i, Unit& u) const {
        const long L = (long)i * G + c; if (L >= nwg) return false;
        int wgid = (int)L; { const int q = nwg / NXCD, r = nwg % NXCD, xcd = wgid % NXCD, off = wgid / NXCD; wgid = (xcd < r ? xcd * (q + 1) : r * (q + 1) + (xcd - r) * q) + off; }
        const int nig = WGM * nN, gid = wgid / nig, fm = gid * WGM, gsz = (nM - fm) < WGM ? (nM - fm) : WGM;
        u.pm = fm + ((wgid % nig) % gsz); u.pn = (wgid % nig) / gsz; return true;
    }
    __device__ __forceinline__ void a_ready(const Unit&) const {}
    __device__ __forceinline__ void done(const Unit&) const {}
};
__device__ __forceinline__ unsigned cvt_pk_bf16(float lo, float hi) { unsigned r; asm volatile("v_cvt_pk_bf16_f32 %0, %1, %2" : "=v"(r) : "v"(lo), "v"(hi)); return r; }
typedef float f32x2 __attribute__((ext_vector_type(2)));
__device__ __forceinline__ float sigm(float x) { return __builtin_amdgcn_rcpf(1.f + __expf(-x)); }
__device__ __forceinline__ int mod_row(int r) { return r < 16384 ? (r >> 11) : 8 + ((r - 16384) >> 2); }

struct EpiIn {
    static constexpr bool PERM = true, AFTER_DRAIN = false;
    bf16_t *Q, *U; size_t qvg_stride; float* LF; const float* bias; const float* LB;
    __device__ __forceinline__ void operator()(const f32x4 (&acc)[2][2][4][2], const Unit& u, int wr, int wc, int fr, int fq) const {
        const int pn = u.pn, row0 = u.pm * BM + wr * 64 + fr;
        if (pn >= 8) {
            const int cj = 128 * (pn - 8) + wc * 32 + 8 * fq;
            f32x4 ba[2], bb[2];
#pragma unroll
            for (int n = 0; n < 2; ++n) { ba[n] = *(const f32x4*)(bias + 2048 + cj + 4 * n); bb[n] = *(const f32x4*)(bias + 2560 + cj + 4 * n); }
#pragma unroll
            for (int ai = 0; ai < 2; ++ai)
#pragma unroll
                for (int m = 0; m < 4; ++m) {
                    const size_t row = (size_t)(row0 + ai * HALF + m * 16);
                    float o[8];
#pragma unroll
                    for (int n = 0; n < 2; ++n)
#pragma unroll
                        for (int i = 0; i < 4; ++i) { const float a = acc[ai][0][m][n][i] + ba[n][i], b = acc[ai][1][m][n][i] + bb[n][i]; o[4 * n + i] = a * sigm(b); }
                    u32x4 w; w.x = cvt_pk_bf16(o[0], o[1]); w.y = cvt_pk_bf16(o[2], o[3]); w.z = cvt_pk_bf16(o[4], o[5]); w.w = cvt_pk_bf16(o[6], o[7]);
                    *(u32x4*)(U + row * 512 + cj) = w;
                }
        } else {
            const int type = pn >> 1;
            bf16_t* dst = Q + (size_t)(type == 0 ? 0 : type - 1) * qvg_stride;
#pragma unroll
            for (int bj = 0; bj < 2; ++bj) {
                const int oc = (pn & 1) * 256 + bj * HALF + wc * 32 + 8 * fq, zc = type * 512 + oc;
                f32x4 bv[2], lb[2];
#pragma unroll
                for (int n = 0; n < 2; ++n) { bv[n] = *(const f32x4*)(bias + zc + 4 * n); lb[n] = *(const f32x4*)(LB + oc + 4 * n); }
#pragma unroll
                for (int ai = 0; ai < 2; ++ai)
#pragma unroll
                    for (int m = 0; m < 4; ++m) {
                        const size_t row = (size_t)(row0 + ai * HALF + m * 16);
                        float o[8];
                        if (type == 1) {
#pragma unroll
                            for (int n = 0; n < 2; ++n) { f32x4 lf;
#pragma unroll
                                for (int i = 0; i < 4; ++i) { const float v = acc[ai][bj][m][n][i] + bv[n][i]; const float f = lb[n][i] + (1.f - lb[n][i]) * sigm(v); lf[i] = __logf(f); }
                                *(f32x4*)(LF + row * 512 + oc + 4 * n) = lf; }
                        } else {
#pragma unroll
                            for (int n = 0; n < 2; ++n)
#pragma unroll
                                for (int i = 0; i < 4; ++i) { const float v = acc[ai][bj][m][n][i] + bv[n][i]; o[4 * n + i] = (type == 2) ? v : v * sigm(v); }
                            u32x4 w; w.x = cvt_pk_bf16(o[0], o[1]); w.y = cvt_pk_bf16(o[2], o[3]); w.z = cvt_pk_bf16(o[4], o[5]); w.w = cvt_pk_bf16(o[6], o[7]);
                            *(u32x4*)(dst + row * 512 + oc) = w;
                        }
                    }
            }
        }
    }
};

struct EpiRes {
    static constexpr bool PERM = false, AFTER_DRAIN = false;
    const float* xp; const float* xs; float* out; const float* bias; const float* MOD; int goff; float alpha;
    __device__ __forceinline__ void operator()(const f32x4 (&acc)[2][2][4][2], const Unit& u, int wr, int wc, int fr, int fq) const {
        const int row0 = u.pm * BM + wr * 64 + fr, col0 = u.pn * BM + wc * 32 + 4 * fq;
        f32x4 bv[2][2];
#pragma unroll
        for (int bj = 0; bj < 2; ++bj)
#pragma unroll
            for (int n = 0; n < 2; ++n) bv[bj][n] = *(const f32x4*)(bias + col0 + bj * HALF + n * 16);
#pragma unroll
        for (int ai = 0; ai < 2; ++ai)
#pragma unroll
            for (int m = 0; m < 4; ++m) {
                const int r = row0 + ai * HALF + m * 16;
                const float* xr = r < 16384 ? xp + (size_t)r * 1024 : xs + (size_t)(r - 16384) * 1024;
                const float* gr = MOD + (size_t)mod_row(r) * 6144 + goff;
                float* orow = out + (size_t)r * 1024;
#pragma unroll
                for (int bj = 0; bj < 2; ++bj)
#pragma unroll
                    for (int n = 0; n < 2; ++n) { const int c = col0 + bj * HALF + n * 16;
                        const f32x4 xv = *(const f32x4*)(xr + c), gv = *(const f32x4*)(gr + c);
                        const f32x4 o = xv * alpha + (gv + 1.f) * (acc[ai][bj][m][n] + bv[bj][n]);
                        *(f32x4*)(orow + c) = o; }
            }
    }
};

struct EpiUp {
    static constexpr bool PERM = true, AFTER_DRAIN = false;
    bf16_t* O; int ldc; const float* bias;
    __device__ __forceinline__ void operator()(const f32x4 (&acc)[2][2][4][2], const Unit& u, int wr, int wc, int fr, int fq) const {
        const int row0 = u.pm * BM + wr * 64 + fr, col0 = u.pn * BM + wc * 32 + 8 * fq;
        f32x4 bv[2][2];
#pragma unroll
        for (int bj = 0; bj < 2; ++bj)
#pragma unroll
            for (int n = 0; n < 2; ++n) bv[bj][n] = *(const f32x4*)(bias + col0 + bj * HALF + 4 * n);
#pragma unroll
        for (int ai = 0; ai < 2; ++ai)
#pragma unroll
            for (int m = 0; m < 4; ++m) { bf16_t* rowp = O + (size_t)(row0 + ai * HALF + m * 16) * ldc + col0;
#pragma unroll
                for (int bj = 0; bj < 2; ++bj) { f32x4 v0 = acc[ai][bj][m][0] + bv[bj][0], v1 = acc[ai][bj][m][1] + bv[bj][1];
#pragma unroll
                    for (int i = 0; i < 4; ++i) { const float a = fmaxf(v0[i], 0.f), b = fmaxf(v1[i], 0.f); v0[i] = a * a; v1[i] = b * b; }
                    u32x4 w; w.x = cvt_pk_bf16(v0[0], v0[1]); w.y = cvt_pk_bf16(v0[2], v0[3]); w.z = cvt_pk_bf16(v1[0], v1[1]); w.w = cvt_pk_bf16(v1[2], v1[3]);
                    *(u32x4*)(rowp + bj * HALF) = w; } }
    }
};
template <class Epi, class Sched, bool ALIGN_EPI = false, bool SP2 = false>
__device__ __forceinline__ void gemm_phase(PG8_LAS unsigned char* lds, const Gemm g, const Sched& S, const Epi& E) {
    const int tid = threadIdx.x, wid = __builtin_amdgcn_readfirstlane(tid >> 6), lane = tid & 63, wr = wid >> 2, wc = wid & 3, fr = lane & 15, fq = lane >> 4;
    const int K = g.K, nt = K / BK;
    unsigned voffA[2], voffB[2];
#pragma unroll
    for (int i = 0; i < 2; ++i) { int R, C; stage_rc(tid * 16 + i * 8192, R, C); const int Rb = Epi::PERM ? ((R & ~31) + perm32(R & 31)) : R;
        voffA[i] = (unsigned)(R * K + C) * 2u; voffB[i] = (unsigned)(Rb * K + C) * 2u; }
    const size_t kstep = (size_t)(BK * 2);
    const size_t hstep = (size_t)HALF * K * 2;
    const size_t tstep = 2 * hstep;
    const unsigned ldsw = (unsigned)wid * 1024u;
    const int aoff = lds_byte(wr * 64 + fr, fq * 8), boff = lds_byte(wc * 32 + fr, fq * 8);
#define PG8_SA(b, h) (((b) * 2 + (h)) * HTB)
#define PG8_SB(b, h) ((4 + (b) * 2 + (h)) * HTB)
#define PG8_STAGE(bufoff, gbase, voff) do { _Pragma("unroll") for (int _i = 0; _i < 2; ++_i) \
        __builtin_amdgcn_global_load_lds((const unsigned*)((const char*)(gbase) + (voff)[_i]), (PG8_LAS unsigned*)(lds + (bufoff) + ldsw + _i * 8192), 16, 0, 0); } while (0)
#define PG8_LDA(dst, b, h) do { _Pragma("unroll") for (int m = 0; m < 4; ++m) _Pragma("unroll") for (int k = 0; k < 2; ++k) dst[m][k] = *(const PG8_LAS bf16x8*)(lds + PG8_SA(b, h) + aoff + m * 2048 + k * 1024); } while (0)
#define PG8_LDB(dst, b, h) do { _Pragma("unroll") for (int n = 0; n < 2; ++n) _Pragma("unroll") for (int k = 0; k < 2; ++k) dst[n][k] = *(const PG8_LAS bf16x8*)(lds + PG8_SB(b, h) + boff + n * 2048 + k * 1024); } while (0)
#define PG8_MMA(ai, bj, At, Bt) do { __builtin_amdgcn_s_setprio(1); _Pragma("unroll") for (int m = 0; m < 4; ++m) _Pragma("unroll") for (int n = 0; n < 2; ++n) _Pragma("unroll") for (int k = 0; k < 2; ++k) \
        acc[ai][bj][m][n] = __builtin_amdgcn_mfma_f32_16x16x32_bf16(Bt[n][k], At[m][k], acc[ai][bj][m][n], 0, 0, 0); __builtin_amdgcn_s_setprio(0); } while (0)
#define PG8_WAIT_V(n) asm volatile("s_waitcnt vmcnt(" #n ")" ::: "memory")
#define PG8_WAIT_L(n) asm volatile("s_waitcnt lgkmcnt(" #n ")" ::: "memory")
#define PG8_BAR __builtin_amdgcn_s_barrier()
#define PG8_SCHED __builtin_amdgcn_sched_barrier(0)
    Unit cur, nxt; int ui = 0;
    if (!S.next(0, cur)) return;
    f32x4 acc[2][2][4][2];
#pragma unroll
    for (int a = 0; a < 2; ++a)
#pragma unroll
        for (int b = 0; b < 2; ++b)
#pragma unroll
            for (int m = 0; m < 4; ++m)
#pragma unroll
                for (int n = 0; n < 2; ++n) acc[a][b][m][n] = (f32x4){0.f, 0.f, 0.f, 0.f};
    bf16x8 At[4][2], B0[2][2], B1[2][2];
    const char* cA = (const char*)g.A + (size_t)cur.pm * tstep; const char* cB = (const char*)g.Bt + (size_t)cur.pn * tstep;
    S.a_ready(cur);
    if constexpr (SP2) {
        PG8_STAGE(PG8_SB(0, 0), cB, voffB); PG8_STAGE(PG8_SB(0, 1), cB + hstep, voffB); PG8_STAGE(PG8_SA(0, 0), cA, voffA); PG8_STAGE(PG8_SA(0, 1), cA + hstep, voffA);
        if (wr == 1) PG8_BAR;
        PG8_WAIT_V(2); PG8_BAR;
        PG8_STAGE(PG8_SB(1, 0), cB + kstep, voffB); PG8_STAGE(PG8_SA(1, 0), cA + kstep, voffA); PG8_STAGE(PG8_SB(1, 1), cB + hstep + kstep, voffB);
        PG8_WAIT_V(6); PG8_BAR;
    } else {
        PG8_STAGE(PG8_SB(0, 0), cB, voffB); PG8_STAGE(PG8_SA(0, 0), cA, voffA); PG8_STAGE(PG8_SB(0, 1), cB + hstep, voffB); PG8_STAGE(PG8_SA(0, 1), cA + hstep, voffA);
        if (wr == 1) PG8_BAR;
        PG8_WAIT_V(4); PG8_BAR;
        PG8_STAGE(PG8_SB(1, 0), cB + kstep, voffB); PG8_STAGE(PG8_SA(1, 0), cA + kstep, voffA); PG8_STAGE(PG8_SB(1, 1), cB + hstep + kstep, voffB);
        PG8_WAIT_V(6); PG8_BAR;
    }
    for (;;) {
        const bool has_next = S.next(ui + 1, nxt);
        const char* nA = has_next ? (const char*)g.A + (size_t)nxt.pm * tstep : cA; const char* nB = has_next ? (const char*)g.Bt + (size_t)nxt.pn * tstep : cB;
        for (int t = 0; t < nt; t += 2) {
            const bool last = (t == nt - 2);
            const char* a1 = cA + (size_t)(t + 1) * kstep;
            const char* a2 = last ? nA : cA + (size_t)(t + 2) * kstep; const char* b2 = last ? nB : cB + (size_t)(t + 2) * kstep;
            const char* a3 = a2 + kstep; const char* b3 = b2 + kstep;
            if (last && has_next) S.a_ready(nxt);
            if constexpr (SP2) {
            PG8_LDB(B0, 0, 0); PG8_LDB(B1, 0, 1); PG8_SCHED; PG8_LDA(At, 0, 0); PG8_STAGE(PG8_SA(1, 1), a1 + hstep, voffA);
            PG8_WAIT_V(8); PG8_WAIT_L(0); PG8_BAR; PG8_MMA(0, 0, At, B0); PG8_MMA(0, 1, At, B1); PG8_BAR; PG8_SCHED;
            PG8_LDA(At, 0, 1); PG8_STAGE(PG8_SB(0, 0), b2, voffB); PG8_STAGE(PG8_SB(0, 1), b2 + hstep, voffB); PG8_STAGE(PG8_SA(0, 0), a2, voffA);
            PG8_WAIT_V(8); PG8_WAIT_L(0); PG8_BAR; PG8_MMA(1, 0, At, B0); PG8_MMA(1, 1, At, B1); PG8_BAR; PG8_SCHED;
            PG8_LDB(B0, 1, 0); PG8_LDB(B1, 1, 1); PG8_SCHED; PG8_LDA(At, 1, 0); PG8_STAGE(PG8_SA(0, 1), a2 + hstep, voffA);
            PG8_WAIT_V(8); PG8_WAIT_L(0); PG8_BAR; PG8_MMA(0, 0, At, B0); PG8_MMA(0, 1, At, B1); PG8_BAR; PG8_SCHED;
            PG8_LDA(At, 1, 1); PG8_STAGE(PG8_SB(1, 0), b3, voffB); PG8_STAGE(PG8_SB(1, 1), b3 + hstep, voffB); PG8_STAGE(PG8_SA(1, 0), a3, voffA);
            PG8_WAIT_V(8); PG8_WAIT_L(0); PG8_BAR; PG8_MMA(1, 0, At, B0); PG8_MMA(1, 1, At, B1); PG8_BAR; PG8_SCHED;
            } else {
            PG8_LDB(B0, 0, 0); PG8_SCHED; PG8_LDA(At, 0, 0); PG8_STAGE(PG8_SA(1, 1), a1 + hstep, voffA);
            PG8_WAIT_L(8); PG8_BAR; PG8_WAIT_L(0); PG8_MMA(0, 0, At, B0); PG8_BAR; PG8_SCHED;
            PG8_LDB(B1, 0, 1); PG8_STAGE(PG8_SB(0, 0), b2, voffB);
            PG8_BAR; PG8_WAIT_L(0); PG8_MMA(0, 1, At, B1); PG8_BAR;
            PG8_LDA(At, 0, 1); PG8_STAGE(PG8_SA(0, 0), a2, voffA);
            PG8_BAR; PG8_WAIT_L(0); PG8_MMA(1, 0, At, B0); PG8_BAR; PG8_SCHED;
            PG8_STAGE(PG8_SB(0, 1), b2 + hstep, voffB);
            PG8_WAIT_V(6); PG8_BAR; PG8_MMA(1, 1, At, B1); PG8_BAR;
            PG8_LDB(B0, 1, 0); PG8_SCHED; PG8_LDA(At, 1, 0); PG8_STAGE(PG8_SA(0, 1), a2 + hstep, voffA);
            PG8_WAIT_L(8); PG8_BAR; PG8_WAIT_L(0); PG8_MMA(0, 0, At, B0); PG8_BAR; PG8_SCHED;
            PG8_LDB(B1, 1, 1); PG8_STAGE(PG8_SB(1, 0), b3, voffB);
            PG8_BAR; PG8_WAIT_L(0); PG8_MMA(0, 1, At, B1); PG8_BAR;
            PG8_LDA(At, 1, 1); PG8_STAGE(PG8_SA(1, 0), a3, voffA);
            PG8_BAR; PG8_WAIT_L(0); PG8_MMA(1, 0, At, B0); PG8_BAR; PG8_SCHED;
            PG8_STAGE(PG8_SB(1, 1), b3 + hstep, voffB);
            PG8_WAIT_V(6); PG8_BAR; PG8_MMA(1, 1, At, B1); PG8_BAR;
            }
        }
        if constexpr (ALIGN_EPI) { if (wr == 0) PG8_BAR; }
        if constexpr (!Epi::AFTER_DRAIN) { E(acc, cur, wr, wc, fr, fq); S.done(cur); }
        if (!has_next) break;
#pragma unroll
        for (int a = 0; a < 2; ++a)
#pragma unroll
            for (int b = 0; b < 2; ++b)
#pragma unroll
                for (int m = 0; m < 4; ++m)
#pragma unroll
                    for (int n = 0; n < 2; ++n) acc[a][b][m][n] = (f32x4){0.f, 0.f, 0.f, 0.f};
        cur = nxt; cA = nA; cB = nB; ++ui;
        if constexpr (ALIGN_EPI) { if (wr == 1) PG8_BAR; }
    }
    PG8_WAIT_V(0);
    if constexpr (!ALIGN_EPI) { if (wr == 0) PG8_BAR; }
    PG8_BAR;
    if constexpr (Epi::AFTER_DRAIN) { E.fused(acc, cur, wr, wc, fr, fq, lds, wid, lane); S.done(cur); }
#undef PG8_SA
#undef PG8_SB
#undef PG8_STAGE
#undef PG8_LDA
#undef PG8_LDB
#undef PG8_MMA
#undef PG8_WAIT_V
#undef PG8_WAIT_L
#undef PG8_BAR
#undef PG8_SCHED
}
}

constexpr int NWAVES = 8, NT = NWAVES * 64;
constexpr int MP = 16384, MS = 512, M = MP + MS, D = 1024, NIN = 3072, FF = 4096, HW = 512, SEQ = 2048;
constexpr float LN_EPS = 1e-5f;
constexpr float ALPHA = 1.189207115002721f;
constexpr size_t MiB = 1u << 20;
constexpr size_t WS_WIN = 0, WS_WOUT = 6 * MiB, WS_WUP = 8 * MiB, WS_WDN = 16 * MiB, WS_MOD = 24 * MiB, WS_LB = 28 * MiB, WS_H = 29 * MiB;
constexpr size_t WS_Q = 62 * MiB, WS_V = WS_Q + (size_t)M * HW * 2, WS_G = WS_V + (size_t)M * HW * 2, WS_U = WS_G + (size_t)M * HW * 2, WS_LF = WS_U + (size_t)M * HW * 2;
constexpr size_t WS_MIX = WS_LF + (size_t)M * HW * 4, WS_HB = 62 * MiB, WS_END = WS_HB + (size_t)M * FF * 2;
static_assert(WS_MIX + (size_t)M * D * 2 == WS_END && WS_END <= 256 * MiB && WS_H + (size_t)M * D * 2 <= WS_Q, "d_ws map");
constexpr size_t WS_CTL = 28 * MiB + 768 * 1024, CTL_BYTES = 16384;
constexpr int LDS_BYTES = 147456;

#define LAS __attribute__((address_space(3)))
typedef unsigned short bf16;
typedef short bf16x8 __attribute__((ext_vector_type(8)));
typedef float f32x4 __attribute__((ext_vector_type(4)));
typedef float f32x16 __attribute__((ext_vector_type(16)));
typedef unsigned u32x4 __attribute__((ext_vector_type(4)));
typedef unsigned u32x2 __attribute__((ext_vector_type(2)));
#define DI __device__ __forceinline__
#define MFMA32(a, b, c) __builtin_amdgcn_mfma_f32_32x32x16_bf16((a), (b), (c), 0, 0, 0)
DI float bf2f(unsigned short b) { return __uint_as_float((unsigned)b << 16); }
DI unsigned f2bf(float f) { unsigned u = __float_as_uint(f); return (u + 0x7fffu + ((u >> 16) & 1u)) >> 16; }
DI unsigned pk2(float lo, float hi) { return f2bf(lo) | (f2bf(hi) << 16); }
DI float sigm(float x) { return __builtin_amdgcn_rcpf(1.f + __expf(-x)); }
DI int crow(int reg, int h) { return (reg & 3) + 8 * (reg >> 2) + 4 * h; }
DI int mod_row(int r) { return r < MP ? (r >> 11) : 8 + ((r - MP) >> 2); }
DI float wave_sum(float v) {
#pragma unroll
    for (int o = 1; o < 64; o <<= 1) v += __shfl_xor(v, o);
    return v;
}
DI f32x16 zero16() { f32x16 z;
#pragma unroll
    for (int i = 0; i < 16; ++i) z[i] = 0.f;
    return z; }

DI void p0_transpose_item(const float* W, int K, int N, bf16* WT, int k0, int n0, int drow0, LAS float* scr, int lane) {
#pragma unroll 8
    for (int i = 0; i < 32; ++i) { const int kk = 2 * i + (lane >> 5); scr[kk * 33 + (lane & 31)] = W[(size_t)(k0 + kk) * N + n0 + (lane & 31)]; }
    asm volatile("s_waitcnt lgkmcnt(0)" ::: "memory");
    const int c = lane & 7;
#pragma unroll
    for (int j = 0; j < 4; ++j) { const int n = (lane >> 3) + 8 * j; const LAS float* s = scr + (8 * c) * 33 + n;
        u32x4 o; o.x = pk2(s[0 * 33], s[1 * 33]); o.y = pk2(s[2 * 33], s[3 * 33]); o.z = pk2(s[4 * 33], s[5 * 33]); o.w = pk2(s[6 * 33], s[7 * 33]);
        *(u32x4*)(WT + (size_t)(drow0 + n) * K + k0 + 8 * c) = o; }
    asm volatile("s_waitcnt lgkmcnt(0)" ::: "memory");
}
DI int win_dest_row(int n) {
    if (n < 2048) return n;
    if (n < 2560) { const int jj = n - 2048; return 2048 + 256 * (jj >> 7) + (jj & 127); }
    const int jj = n - 2560; return 2048 + 256 * (jj >> 7) + 128 + (jj & 127);
}
DI void p0_mod(LAS unsigned char* lds, const float* cp, const float* cs, const float* w_ada, const float* b_ada, float* MOD, int G) {
    const int tid = threadIdx.x, lane = tid & 63, w = __builtin_amdgcn_readfirstlane(tid >> 6), r = lane & 31, hh = lane >> 5;
    LAS float* red = (LAS float*)lds;
    for (int nt = blockIdx.x; nt < 192; nt += G) {
        const int n0 = nt * 32, kb = w * 128;
        bf16x8 Bf[8];
#pragma unroll
        for (int ks = 0; ks < 8; ++ks) {
            float t[8];
#pragma unroll
            for (int j = 0; j < 8; ++j) t[j] = w_ada[(size_t)(kb + 16 * ks + 8 * hh + j) * 6144 + n0 + r];
            u32x4 p; p.x = pk2(t[0], t[1]); p.y = pk2(t[2], t[3]); p.z = pk2(t[4], t[5]); p.w = pk2(t[6], t[7]);
            Bf[ks] = __builtin_bit_cast(bf16x8, p);
        }
        for (int mt = 0; mt < 5; ++mt) {
            const int row = 32 * mt + r, rc = row < 136 ? row : 135;
            const float* crow_ = rc < 8 ? cp + (size_t)rc * 1024 : cs + (size_t)(rc - 8) * 1024;
            f32x16 acc = zero16();
#pragma unroll
            for (int ks = 0; ks < 8; ++ks) {
                const f32x4 a0 = *(const f32x4*)(crow_ + kb + 16 * ks + 8 * hh), a1 = *(const f32x4*)(crow_ + kb + 16 * ks + 8 * hh + 4);
                u32x4 p; p.x = pk2(a0[0] * sigm(a0[0]), a0[1] * sigm(a0[1])); p.y = pk2(a0[2] * sigm(a0[2]), a0[3] * sigm(a0[3]));
                p.z = pk2(a1[0] * sigm(a1[0]), a1[1] * sigm(a1[1])); p.w = pk2(a1[2] * sigm(a1[2]), a1[3] * sigm(a1[3]));
                acc = MFMA32(__builtin_bit_cast(bf16x8, p), Bf[ks], acc);
            }
#pragma unroll
            for (int reg = 0; reg < 16; ++reg) red[(w * 16 + reg) * 64 + lane] = acc[reg];
            __syncthreads();
#pragma unroll
            for (int i = 0; i < 2; ++i) {
                const int o = tid + 512 * i, reg = o >> 6, ln = o & 63;
                float s = 0.f;
#pragma unroll
                for (int ww = 0; ww < 8; ++ww) s += red[(ww * 16 + reg) * 64 + ln];
                const int rowo = 32 * mt + crow(reg, ln >> 5), col = n0 + (ln & 31);
                if (rowo < 136) MOD[(size_t)rowo * 6144 + col] = s + b_ada[col];
            }
            __syncthreads();
        }
    }
}

constexpr int HQ_QE = 0, HQ_KE = 17408, HQ_KDT = 34816, HQ_VT = 53248, HQ_ATT = 71680, HQ_SEG = 80896;
DI void hgrn_pass1_unit(LAS unsigned char* lds, int u, const bf16* Q, bf16* QEo, const float* LF, const bf16* V, float* OI, float* DS, float* EBLg) {
    const int tid = threadIdx.x, lane = tid & 63, w = __builtin_amdgcn_readfirstlane(tid >> 6), r = lane & 31, hh = lane >> 5;
    LAS bf16* QE = (LAS bf16*)(lds + HQ_QE); LAS bf16* KE = (LAS bf16*)(lds + HQ_KE);
    LAS bf16* KDT = (LAS bf16*)(lds + HQ_KDT); LAS bf16* VT = (LAS bf16*)(lds + HQ_VT); LAS bf16* ATT = (LAS bf16*)(lds + HQ_ATT);
    LAS float* SEG = (LAS float*)(lds + HQ_SEG);
    const int k = tid & 127, seg = __builtin_amdgcn_readfirstlane(tid >> 7);
    const int vt = w & 3, tt = w >> 2, ktb = 2 * (w >> 2);
    const int bh = u >> 5, c = u & 31, b = bh >> 2, h = bh & 3;
    const size_t rowb = (size_t)b * SEQ + c * 64 + seg * 16, cb = (size_t)h * 128 + k;
    float lf[16], qv[16]; unsigned vr[16];
#pragma unroll
    for (int i = 0; i < 16; ++i) { const size_t off = (rowb + i) * HW + cb; lf[i] = LF[off]; qv[i] = bf2f(Q[off]); vr[i] = V[off]; }
    float ssum = 0.f;
#pragma unroll
    for (int i = 0; i < 16; ++i) ssum += lf[i];
    SEG[seg * 128 + k] = ssum;
    __syncthreads();
    const float s0 = SEG[k], s1 = SEG[128 + k], s2 = SEG[256 + k], s3 = SEG[384 + k];
    const float bl = (s0 + s1) + (s2 + s3);
    float bcur = seg == 0 ? 0.f : (seg == 1 ? s0 : (seg == 2 ? s0 + s1 : (s0 + s1) + s2));
    const float ebl = __expf(bl);
    if (seg == 0) EBLg[(size_t)u * 128 + k] = ebl;
    unsigned kdp[8], vp[8];
#pragma unroll
    for (int i = 0; i < 16; ++i) {
        bcur += lf[i];
        const float eb = __expf(bcur), enb = __builtin_amdgcn_rcpf(eb), kk = 1.f - __expf(lf[i]);
        const float qe = qv[i] * eb, ke = kk * enb, kd = ke * ebl;
        const int t = seg * 16 + i;
        const unsigned qeb = f2bf(qe);
        QE[t * 136 + k] = (bf16)qeb; KE[t * 136 + k] = (bf16)f2bf(ke);
        QEo[(rowb + i) * HW + cb] = (bf16)qeb;
        if (i & 1) { kdp[i >> 1] |= f2bf(kd) << 16; vp[i >> 1] |= vr[i] << 16; } else { kdp[i >> 1] = f2bf(kd); vp[i >> 1] = vr[i]; }
    }
    *(LAS u32x4*)(KDT + k * 72 + seg * 16) = (u32x4){kdp[0], kdp[1], kdp[2], kdp[3]}; *(LAS u32x4*)(KDT + k * 72 + seg * 16 + 8) = (u32x4){kdp[4], kdp[5], kdp[6], kdp[7]};
    *(LAS u32x4*)(VT + k * 72 + seg * 16) = (u32x4){vp[0], vp[1], vp[2], vp[3]}; *(LAS u32x4*)(VT + k * 72 + seg * 16 + 8) = (u32x4){vp[4], vp[5], vp[6], vp[7]};
    __syncthreads();
    if (w < 3) {
        const int at = (w >= 1) ? 1 : 0, as = (w == 2) ? 1 : 0;
        f32x16 acca = zero16();
#pragma unroll
        for (int ks = 0; ks < 8; ++ks) {
            const bf16x8 a = *(const LAS bf16x8*)(QE + (32 * at + r) * 136 + 16 * ks + 8 * hh), bb = *(const LAS bf16x8*)(KE + (32 * as + r) * 136 + 16 * ks + 8 * hh);
            acca = MFMA32(a, bb, acca);
        }
#pragma unroll
        for (int reg = 0; reg < 16; ++reg) { const int tr = crow(reg, hh); float v = acca[reg]; if (at == as && tr < r) v = 0.f; ATT[(32 * at + tr) * 72 + 32 * as + r] = (bf16)f2bf(v); }
    } else if (w == 3) {
#pragma unroll
        for (int reg = 0; reg < 16; ++reg) ATT[crow(reg, hh) * 72 + 32 + r] = (bf16)0;
    }
#pragma unroll
    for (int j = 0; j < 2; ++j) {
        const int kt = ktb + j; f32x16 accd = zero16();
#pragma unroll
        for (int ks = 0; ks < 4; ++ks) {
            const bf16x8 a = *(const LAS bf16x8*)(KDT + (32 * kt + r) * 72 + 16 * ks + 8 * hh), bb = *(const LAS bf16x8*)(VT + (32 * vt + r) * 72 + 16 * ks + 8 * hh);
            accd = MFMA32(a, bb, accd);
        }
        float* dst = DS + (((size_t)u * 16 + kt * 4 + vt) * 4) * 256 + lane * 4;
#pragma unroll
        for (int g4 = 0; g4 < 4; ++g4) *(f32x4*)(dst + g4 * 256) = (f32x4){accd[4 * g4], accd[4 * g4 + 1], accd[4 * g4 + 2], accd[4 * g4 + 3]};
    }
    __syncthreads();
    {
        f32x16 acco = zero16();
#pragma unroll
        for (int ks = 0; ks < 4; ++ks) {
            const bf16x8 a = *(const LAS bf16x8*)(ATT + (32 * tt + r) * 72 + 16 * ks + 8 * hh), bb = *(const LAS bf16x8*)(VT + (32 * vt + r) * 72 + 16 * ks + 8 * hh);
            acco = MFMA32(a, bb, acco);
        }
        float* dst = OI + ((size_t)u * 8 + w) * 1024 + lane * 4;
#pragma unroll
        for (int g4 = 0; g4 < 4; ++g4) *(f32x4*)(dst + g4 * 256) = (f32x4){acco[4 * g4], acco[4 * g4 + 1], acco[4 * g4 + 2], acco[4 * g4 + 3]};
    }
    __syncthreads();
}
DI void hgrn_scan(const float* DS, const float* EBLg, u32x4* SFR, float* NHP, int gtid, int gthreads) {
    for (int item = gtid; item < 32 * 2048; item += gthreads) {
        const int lane = item & 63, s = (item >> 6) & 1, tile = (item >> 7) & 15, bh = item >> 11;
        const int kt = tile >> 2, vt = tile & 3, r = lane & 31, hh = lane >> 5, k0 = 32 * kt + 16 * s + 4 * hh;
        f32x4 S0 = (f32x4){0.f, 0.f, 0.f, 0.f}, S1 = S0;
        for (int c4 = 0; c4 < 32; c4 += 4) {
            f32x4 d0[4], d1[4], e0[4], e1[4];
#pragma unroll
            for (int i = 0; i < 4; ++i) { const size_t u = (size_t)bh * 32 + c4 + i;
                d0[i] = *(const f32x4*)(DS + ((u * 16 + tile) * 4 + 2 * s) * 256 + lane * 4); d1[i] = *(const f32x4*)(DS + ((u * 16 + tile) * 4 + 2 * s + 1) * 256 + lane * 4);
                e0[i] = *(const f32x4*)(EBLg + u * 128 + k0); e1[i] = *(const f32x4*)(EBLg + u * 128 + k0 + 8); }
#pragma unroll
            for (int i = 0; i < 4; ++i) { const size_t u = (size_t)bh * 32 + c4 + i;
                SFR[((u * 16 + tile) * 2 + s) * 64 + lane] = (u32x4){pk2(S0[0], S0[1]), pk2(S0[2], S0[3]), pk2(S1[0], S1[1]), pk2(S1[2], S1[3])};
                S0 = S0 * e0[i] + d0[i]; S1 = S1 * e1[i] + d1[i]; }
        }
        float* dst = NHP + ((size_t)bh * 128 + k0) * 128 + 32 * vt + r;
#pragma unroll
        for (int i = 0; i < 4; ++i) { dst[i * 128] = S0[i]; dst[(8 + i) * 128] = S1[i]; }
    }
}
DI void hgrn_pass3_unit(LAS unsigned char* lds, int u, const bf16* QEg, const float* OI, const u32x4* SFR, const bf16* Gt, const float* hgw, bf16* MIX) {
    const int tid = threadIdx.x, lane = tid & 63, w = __builtin_amdgcn_readfirstlane(tid >> 6), r = lane & 31, hh = lane >> 5;
    LAS float* OST = (LAS float*)lds;
    const int vt = w & 3, tt = w >> 2;
    const int bh = u >> 5, c = u & 31, b = bh >> 2, h = bh & 3;
    f32x16 acc;
    {
        const float* src = OI + ((size_t)u * 8 + w) * 1024 + lane * 4;
#pragma unroll
        for (int g4 = 0; g4 < 4; ++g4) { const f32x4 t4 = *(const f32x4*)(src + g4 * 256); acc[4 * g4] = t4[0]; acc[4 * g4 + 1] = t4[1]; acc[4 * g4 + 2] = t4[2]; acc[4 * g4 + 3] = t4[3]; }
    }
    const bf16* qrow = QEg + ((size_t)b * SEQ + c * 64 + 32 * tt + r) * HW + h * 128 + 4 * hh;
#pragma unroll
    for (int kt = 0; kt < 4; ++kt)
#pragma unroll
        for (int s = 0; s < 2; ++s) {
            const u32x2 alo = *(const u32x2*)(qrow + 32 * kt + 16 * s), ahi = *(const u32x2*)(qrow + 32 * kt + 16 * s + 8);
            const u32x4 av = (u32x4){alo.x, alo.y, ahi.x, ahi.y};
            const u32x4 bv = SFR[(((size_t)u * 16 + kt * 4 + vt) * 2 + s) * 64 + lane];
            acc = MFMA32(__builtin_bit_cast(bf16x8, av), __builtin_bit_cast(bf16x8, bv), acc);
        }
#pragma unroll
    for (int reg = 0; reg < 16; ++reg) OST[(32 * tt + crow(reg, hh)) * 132 + 32 * vt + r] = acc[reg];
    __syncthreads();
    {
        const int t = tid >> 3, part = tid & 7; const size_t row = (size_t)b * SEQ + c * 64 + t;
        f32x4 o[4]; float ssq = 0.f;
#pragma unroll
        for (int j = 0; j < 4; ++j) { o[j] = *(const LAS f32x4*)(OST + t * 132 + 16 * part + 4 * j); ssq += (o[j][0] * o[j][0] + o[j][1] * o[j][1]) + (o[j][2] * o[j][2] + o[j][3] * o[j][3]); }
        ssq += __shfl_xor(ssq, 1); ssq += __shfl_xor(ssq, 2); ssq += __shfl_xor(ssq, 4);
        const float rs = rsqrtf(ssq * (1.f / 128.f) + LN_EPS);
        const u32x4 g0 = *(const u32x4*)(Gt + row * HW + h * 128 + 16 * part), g1 = *(const u32x4*)(Gt + row * HW + h * 128 + 16 * part + 8);
        const unsigned gw_[8] = {g0.x, g0.y, g0.z, g0.w, g1.x, g1.y, g1.z, g1.w};
        unsigned ow[8];
#pragma unroll
        for (int j = 0; j < 4; ++j) {
            const f32x4 wv = *(const f32x4*)(hgw + 16 * part + 4 * j);
            const float a0 = o[j][0] * rs * wv[0] * bf2f((unsigned short)(gw_[2 * j] & 0xffffu)), a1 = o[j][1] * rs * wv[1] * bf2f((unsigned short)(gw_[2 * j] >> 16));
            const float a2 = o[j][2] * rs * wv[2] * bf2f((unsigned short)(gw_[2 * j + 1] & 0xffffu)), a3 = o[j][3] * rs * wv[3] * bf2f((unsigned short)(gw_[2 * j + 1] >> 16));
            ow[2 * j] = pk2(a0, a1); ow[2 * j + 1] = pk2(a2, a3);
        }
        *(u32x4*)(MIX + row * D + h * 128 + 16 * part) = (u32x4){ow[0], ow[1], ow[2], ow[3]}; *(u32x4*)(MIX + row * D + h * 128 + 16 * part + 8) = (u32x4){ow[4], ow[5], ow[6], ow[7]};
    }
    __syncthreads();
}

DI void hgrn_sample_unit(LAS unsigned char* lds, int b, int h, const bf16* Q, const float* LF, const bf16* V, const bf16* Gt, const float* hgw, const float* S0, bf16* MIX, float* Sout) {
    const int tid = threadIdx.x, lane = tid & 63, w = __builtin_amdgcn_readfirstlane(tid >> 6);
    LAS float* qeS = (LAS float*)lds; LAS float* keS = qeS + 512; LAS float* kdS = qeS + 1024; LAS float* vS = qeS + 1536; LAS float* eblS = qeS + 2048;
    LAS float* attS = qeS + 2176; LAS float* opart = qeS + 2240; LAS float* ssqS = qeS + 2240 + 2048;
    const size_t row0 = (size_t)MP + 4 * b;
    if (tid < 128) {
        const int k = tid; float lfv[4], qq[4];
#pragma unroll
        for (int t = 0; t < 4; ++t) { const size_t off = (row0 + t) * HW + h * 128 + k; lfv[t] = LF[off]; qq[t] = bf2f(Q[off]); }
        const float bl = (lfv[0] + lfv[1]) + (lfv[2] + lfv[3]); float bc = 0.f;
#pragma unroll
        for (int t = 0; t < 4; ++t) { bc += lfv[t]; const float kk = 1.f - __expf(lfv[t]);
            qeS[t * 128 + k] = qq[t] * __expf(bc); keS[t * 128 + k] = kk * __expf(-bc); kdS[t * 128 + k] = kk * __expf(bl - bc); }
        eblS[k] = __expf(bl);
    } else if (tid < 256) {
        const int v = tid - 128;
#pragma unroll
        for (int t = 0; t < 4; ++t) vS[t * 128 + v] = bf2f(V[(row0 + t) * HW + h * 128 + v]);
    }
    __syncthreads();
    if (w < 4) {
        const int t = w;
        for (int s = 0; s <= t; ++s) {
            float p = qeS[t * 128 + lane] * keS[s * 128 + lane] + qeS[t * 128 + 64 + lane] * keS[s * 128 + 64 + lane];
            p = wave_sum(p);
            if (lane == 0) attS[t * 4 + s] = p;
        }
    }
    {
        const int v = tid & 127, kq = tid >> 7;
        float op[4] = {0.f, 0.f, 0.f, 0.f};
        const float* S0p = S0 + ((size_t)(b * 4 + h) * 128 + 32 * kq) * 128 + v; float* Snp = Sout + ((size_t)(b * 4 + h) * 128 + 32 * kq) * 128 + v;
        const float v0 = vS[v], v1 = vS[128 + v], v2 = vS[256 + v], v3 = vS[384 + v];
        float s0v[32];
#pragma unroll
        for (int kk = 0; kk < 32; ++kk) s0v[kk] = __builtin_nontemporal_load(S0p + kk * 128);
#pragma unroll
        for (int kk = 0; kk < 32; ++kk) {
            const int k = 32 * kq + kk; const float s0 = s0v[kk];
            op[0] += qeS[k] * s0; op[1] += qeS[128 + k] * s0; op[2] += qeS[256 + k] * s0; op[3] += qeS[384 + k] * s0;
            __builtin_nontemporal_store(eblS[k] * s0 + ((kdS[k] * v0 + kdS[128 + k] * v1) + (kdS[256 + k] * v2 + kdS[384 + k] * v3)), Snp + kk * 128);
        }
#pragma unroll
        for (int t = 0; t < 4; ++t) opart[(kq * 4 + t) * 128 + v] = op[t];
    }
    __syncthreads();
    {
        const int t = tid >> 7, v = tid & 127;
        float o = (opart[t * 128 + v] + opart[(4 + t) * 128 + v]) + (opart[(8 + t) * 128 + v] + opart[(12 + t) * 128 + v]);
        for (int s = 0; s <= t; ++s) o += attS[t * 4 + s] * vS[s * 128 + v];
        const float q = wave_sum(o * o);
        if (lane == 0) ssqS[w] = q;
        __syncthreads();
        const float rs = rsqrtf((ssqS[2 * t] + ssqS[2 * t + 1]) * (1.f / 128.f) + LN_EPS);
        const float res = o * rs * hgw[v] * bf2f(Gt[(row0 + t) * HW + h * 128 + v]);
        MIX[(row0 + t) * D + h * 128 + v] = (bf16)f2bf(res);
    }
    __syncthreads();
}

DI float conv_post(float acc, float gg, float gb) {
    const float mean = wave_sum(acc) * (1.f / 64.f), d = acc - mean;
    const float var = wave_sum(d * d) * (1.f / 64.f);
    const float y = d * rsqrtf(var + LN_EPS) * gg + gb;
    return y * sigm(y);
}
DI void conv_prompt_unit(int b, int tb, const bf16* U, const float (&cw)[31], float cbias, float gg, float gb, bf16* MIX, float* NCP) {
    const int c = threadIdx.x, t0 = 8 * tb;
    float win[38];
#pragma unroll
    for (int j = 0; j < 38; ++j) { const int tok = t0 - 30 + j, tc = tok < 0 ? 0 : tok; const float v = bf2f(U[((size_t)b * SEQ + tc) * HW + c]); win[j] = tok < 0 ? 0.f : v; }
#pragma unroll
    for (int i = 0; i < 8; ++i) {
        float acc = cbias;
#pragma unroll
        for (int j = 0; j < 31; ++j) acc += cw[j] * win[i + j];
        const float o = conv_post(acc, gg, gb);
        MIX[((size_t)b * SEQ + t0 + i) * D + 512 + c] = (bf16)f2bf(o);
        if (t0 + i >= SEQ - 30) NCP[((size_t)b * 30 + (t0 + i - (SEQ - 30))) * HW + c] = win[30 + i];
    }
}
DI void conv_sample_unit(int b, const bf16* U, const float* sconv, const float (&cw)[31], float cbias, float gg, float gb, bf16* MIX, float* NCS) {
    const int c = threadIdx.x;
    float full[34];
#pragma unroll
    for (int j = 0; j < 30; ++j) full[j] = sconv[((size_t)b * 30 + j) * HW + c];
#pragma unroll
    for (int t = 0; t < 4; ++t) full[30 + t] = bf2f(U[((size_t)MP + 4 * b + t) * HW + c]);
#pragma unroll
    for (int t = 0; t < 4; ++t) {
        float acc = cbias;
#pragma unroll
        for (int j = 0; j < 31; ++j) acc += cw[j] * full[t + j];
        const float o = conv_post(acc, gg, gb);
        MIX[((size_t)MP + 4 * b + t) * D + 512 + c] = (bf16)f2bf(o);
    }
#pragma unroll
    for (int j = 0; j < 30; ++j) NCS[((size_t)b * 30 + j) * HW + c] = full[4 + j];
}

template <bool WITH_H>
DI void ln_rows(float* io, const float* g, const float* bta, const float* MOD, int shoff, bf16* H, int gw, int ngw, int lane) {
    for (int m = gw; m < M; m += ngw) {
        float* row = io + (size_t)m * D;
        f32x4 v[4]; float s = 0.f;
#pragma unroll
        for (int j = 0; j < 4; ++j) { v[j] = *(const f32x4*)(row + 4 * lane + 256 * j); s += (v[j][0] + v[j][1]) + (v[j][2] + v[j][3]); }
        const float mean = wave_sum(s) * (1.f / D); float s2 = 0.f;
#pragma unroll
        for (int j = 0; j < 4; ++j) { v[j] = v[j] - mean; s2 += (v[j][0] * v[j][0] + v[j][1] * v[j][1]) + (v[j][2] * v[j][2] + v[j][3] * v[j][3]); }
        const float rstd = rsqrtf(wave_sum(s2) * (1.f / D) + LN_EPS);
        const float* mr = MOD + (size_t)mod_row(m) * 6144 + shoff;
#pragma unroll
        for (int j = 0; j < 4; ++j) {
            const int col = 4 * lane + 256 * j;
            const f32x4 gv = *(const f32x4*)(g + col), bv = *(const f32x4*)(bta + col);
            const f32x4 x1 = v[j] * rstd * gv + bv;
            *(f32x4*)(row + col) = x1;
            if (WITH_H) { const f32x4 sh = *(const f32x4*)(mr + col), sc = *(const f32x4*)(mr + 1024 + col); const f32x4 hv = x1 * (sc + 1.f) + sh;
                *(u32x2*)(H + (size_t)m * D + col) = (u32x2){pk2(hv[0], hv[1]), pk2(hv[2], hv[3])}; }
        }
    }
}

#define XB_TMO      128
#define XB_XCNT(j)  (256  + 64 * (j))
#define XB_XSUB(j)  (1280 + 64 * (j))
#define XB_XGEN(j)  (2304 + 64 * (j))
#define XB_TOP      3328
#define XB_TOPGEN   3392
#define XCD_BAR_WORDS 3456
#define XB_SPIN_CAP (1u << 18)

__device__ __forceinline__ unsigned xb_ld(unsigned* p)              { return __hip_atomic_load(p, __ATOMIC_RELAXED, __HIP_MEMORY_SCOPE_AGENT); }
__device__ __forceinline__ unsigned xb_add(unsigned* p, unsigned v) { return __hip_atomic_fetch_add(p, v, __ATOMIC_RELAXED, __HIP_MEMORY_SCOPE_AGENT); }
__device__ __forceinline__ unsigned xb_xcc_id() { return (unsigned)__builtin_amdgcn_s_getreg((3 << 11) | 20) & 0xFu; }
#define XB_SPIN(cond, bar) do { unsigned _sp = 0; while (cond) { __builtin_amdgcn_s_sleep(1); \
    if ((++_sp & 255u) == 0u) { if (xb_ld(&(bar)[XB_TMO])) break; if (_sp > XB_SPIN_CAP) { atomicAdd(&(bar)[XB_TMO], 1u); break; } } } } while (0)

struct XcdBarrier {
    unsigned* bar; unsigned x;
    volatile LAS unsigned* st;
};

__device__ __forceinline__ XcdBarrier xcd_barrier_post(unsigned* bar, volatile LAS unsigned* st) {
    XcdBarrier b; b.bar = bar; b.x = xb_xcc_id(); b.st = st;
    if (threadIdx.x == 0) (void)xb_add(&bar[XB_XCNT(b.x)], 1u);
    return b;
}
__device__ __forceinline__ void xcd_barrier_complete(unsigned* bar, unsigned x, unsigned& nloc, unsigned& nx) {
    const unsigned G = gridDim.x * gridDim.y * gridDim.z;
    unsigned sum, cnt, mine, sp = 0u;
    for (;;) {
        sum = 0u; cnt = 0u; mine = 0u;
#pragma unroll
        for (unsigned j = 0; j < 16; ++j) { const unsigned c = xb_ld(&bar[XB_XCNT(j)]); sum += c; cnt += (c > 0u) ? 1u : 0u; mine = (j == x) ? c : mine; }
        if (sum == G) break;
        __builtin_amdgcn_s_sleep(1);
        if ((++sp & 255u) == 0u) { if (xb_ld(&bar[XB_TMO])) break; if (sp > XB_SPIN_CAP) { atomicAdd(&bar[XB_TMO], 1u); break; } }
    }
    nloc = mine > 0u ? mine : 1u; nx = cnt > 0u ? cnt : 1u;
}

__device__ __forceinline__ void xcd_barrier(const XcdBarrier& b) {
    asm volatile("s_waitcnt vmcnt(0)" ::: "memory");
    __syncthreads();
    if (threadIdx.x == 0) {
        unsigned* bar = b.bar;
        __builtin_amdgcn_s_waitcnt(0);
        unsigned nloc = b.st[0], nx = b.st[1];
        if (nloc == 0u) { xcd_barrier_complete(bar, b.x, nloc, nx); b.st[0] = nloc; b.st[1] = nx; }
        const unsigned old = xb_add(&bar[XB_XSUB(b.x)], 1u);
        const unsigned gen = old / nloc;
        if (old + 1u == (gen + 1u) * nloc) {
            __builtin_amdgcn_fence(__ATOMIC_RELEASE, "agent");
            asm volatile("s_waitcnt vmcnt(0)" ::: "memory");
            const unsigned og = xb_add(&bar[XB_TOP], 1u);
            const unsigned tg = og / nx;
            if (og + 1u == (tg + 1u) * nx) xb_add(&bar[XB_TOPGEN], 1u);
            else XB_SPIN(xb_ld(&bar[XB_TOPGEN]) == tg, bar);
            __builtin_amdgcn_fence(__ATOMIC_ACQUIRE, "agent");
            xb_add(&bar[XB_XGEN(b.x)], 1u);
            asm volatile("s_waitcnt vmcnt(0)" ::: "memory");
        } else {
            XB_SPIN(xb_ld(&bar[XB_XGEN(b.x)]) == gen, bar);
            __builtin_amdgcn_fence(__ATOMIC_ACQUIRE, "agent");
            asm volatile("s_waitcnt vmcnt(0)" ::: "memory");
        }
    }
    __syncthreads();
}

struct Args { const float* in[26]; float* out; unsigned char* ws; int ph_lo, ph_hi; };
enum { I_XP = 0, I_XS, I_CP, I_CS, I_SH, I_SC, I_LB, I_WIN, I_BIN, I_HGW, I_CW, I_CB, I_GNG, I_GNB, I_WOUT, I_BOUT, I_LN1G, I_LN1B, I_WUP, I_BUP, I_WDN, I_BDN, I_LN2G, I_LN2B, I_WADA, I_BADA };
constexpr int N_PHASES = 11;
#ifndef REP_CONV
#define REP_CONV 1
#define REP_SAMP 1
#endif
#ifndef PROBE_DUP
#define PROBE_DUP -1
#endif

__global__ void __launch_bounds__(NT, 2) fwd_kernel(Args args) {
    extern __shared__ __attribute__((aligned(16))) unsigned char lds_raw[];
    LAS unsigned char* lds = (LAS unsigned char*)lds_raw;
    const int tid = threadIdx.x, lane = tid & 63, wave = __builtin_amdgcn_readfirstlane(tid >> 6);
    const int G = gridDim.x, bx = blockIdx.x;
    const int gw = bx * NWAVES + wave, ngw = G * NWAVES;
    unsigned char* ws = args.ws;
    const float* xp = args.in[I_XP]; const float* xs = args.in[I_XS];
    float* out = args.out;
    float* y = out;
    float* NHP = out + (size_t)M * D;
    float* NCP = NHP + (size_t)8 * 4 * 128 * 128;
    float* NHS = NCP + (size_t)8 * 30 * 512;
    float* NCS = NHS + (size_t)128 * 4 * 128 * 128;
    bf16* WTin = (bf16*)(ws + WS_WIN); bf16* WTout = (bf16*)(ws + WS_WOUT); bf16* WTup = (bf16*)(ws + WS_WUP); bf16* WTdn = (bf16*)(ws + WS_WDN);
    float* MOD = (float*)(ws + WS_MOD); float* LBv = (float*)(ws + WS_LB);
    bf16* Hb = (bf16*)(ws + WS_H); bf16* Qb = (bf16*)(ws + WS_Q); bf16* Vb = (bf16*)(ws + WS_V); bf16* Gb = (bf16*)(ws + WS_G); bf16* Ub = (bf16*)(ws + WS_U);
    float* LFb = (float*)(ws + WS_LF); bf16* MIX = (bf16*)(ws + WS_MIX); bf16* HB = (bf16*)(ws + WS_HB);
    const int lo = args.ph_lo, hi = args.ph_hi;
    volatile LAS unsigned* xst = (volatile LAS unsigned*)(lds + 131072 + 512);
    if (tid < 2) xst[tid] = 0u;
    __syncthreads();
    XcdBarrier xbar; xbar.bar = (unsigned*)(ws + WS_CTL); xbar.x = 0; xbar.st = xst;
    if (hi - lo > 1) xbar = xcd_barrier_post((unsigned*)(ws + WS_CTL), xst);
#define IN(k) (lo <= (k) && (k) < hi)
#define SEAM(k) do { if (IN(k) && IN((k) + 1)) { if ((k) == 0) cg::this_grid().sync(); else xcd_barrier(xbar); } } while (0)

    if (IN(0)) {
        p0_mod(lds, args.in[I_CP], args.in[I_CS], args.in[I_WADA], args.in[I_BADA], MOD, G);
        __syncthreads();
        LAS float* scr = (LAS float*)(lds + wave * 16384);
        constexpr int IT_IN = 16 * 96, IT_OUT = 16 * 32, IT_UP = 16 * 128, IT_DN = 64 * 32, NITEMS = IT_IN + IT_OUT + IT_UP + IT_DN;
        for (int it = gw; it < NITEMS; it += ngw) {
            int q = it;
            if (q < IT_IN) { const int kb = q / 96, nb = q % 96; p0_transpose_item(args.in[I_WIN], D, NIN, WTin, 64 * kb, 32 * nb, win_dest_row(32 * nb), scr, lane); continue; } q -= IT_IN;
            if (q < IT_OUT) { const int kb = q / 32, nb = q % 32; p0_transpose_item(args.in[I_WOUT], D, D, WTout, 64 * kb, 32 * nb, 32 * nb, scr, lane); continue; } q -= IT_OUT;
            if (q < IT_UP) { const int kb = q / 128, nb = q % 128; p0_transpose_item(args.in[I_WUP], D, FF, WTup, 64 * kb, 32 * nb, 32 * nb, scr, lane); continue; } q -= IT_UP;
            { const int kb = q / 32, nb = q % 32; p0_transpose_item(args.in[I_WDN], FF, D, WTdn, 64 * kb, 32 * nb, 32 * nb, scr, lane); }
        }
        const int gt = bx * NT + tid;
        if (gt < HW) { const float* l = args.in[I_LB]; LBv[gt] = 1.f / (1.f + __expf(l[HW + gt] - l[gt])); }
    }
    SEAM(0);
    if (IN(1)) {
        for (int m = gw; m < M; m += ngw) {
            const float* xr = m < MP ? xp + (size_t)m * D : xs + (size_t)(m - MP) * D;
            const float* mr = MOD + (size_t)mod_row(m) * 6144;
#pragma unroll
            for (int j = 0; j < 4; ++j) { const int col = 4 * lane + 256 * j;
                const f32x4 xv = *(const f32x4*)(xr + col), sh = *(const f32x4*)(mr + col), sc = *(const f32x4*)(mr + 1024 + col);
                const f32x4 hv = xv * (sc + 1.f) + sh;
                *(u32x2*)(Hb + (size_t)m * D + col) = (u32x2){pk2(hv[0], hv[1]), pk2(hv[2], hv[3])}; }
        }
    }
    SEAM(1);
    if (IN(2)) {
        pg8::Gemm g{Hb, WTin, M, NIN, D}; pg8::StaticOrder S; S.init(M, NIN, G, bx);
        pg8::EpiIn E{Qb, Ub, (size_t)M * HW, LFb, args.in[I_BIN], LBv};
        pg8::gemm_phase<pg8::EpiIn, pg8::StaticOrder, true, true>(lds, g, S, E);
    }
    SEAM(2);
    float* OI = (float*)(ws + WS_H); float* EBLg = (float*)(ws + WS_LB + 65536); float* DSg = y; u32x4* SFR = (u32x4*)(ws + WS_LF); bf16* QEb = (bf16*)(ws + 194 * MiB);
    if (IN(3)) {
        for (int u = bx; u < 1024; u += G) hgrn_pass1_unit(lds, u, Qb, QEb, LFb, Vb, OI, DSg, EBLg);
        {
            float cw[31];
#pragma unroll
            for (int j = 0; j < 31; ++j) cw[j] = args.in[I_CW][j * HW + tid];
            const float cbias = args.in[I_CB][tid], gg = args.in[I_GNG][tid], gb = args.in[I_GNB][tid];
            for (int rep = 0; rep < REP_CONV; ++rep)
            for (int u = bx; u < 2048; u += G) conv_prompt_unit(u >> 8, u & 255, Ub, cw, cbias, gg, gb, MIX, NCP);
            for (int u = bx; u < 128; u += G) conv_sample_unit(u, Ub, args.in[I_SC], cw, cbias, gg, gb, MIX, NCS);
        }
        asm volatile("" ::: "memory");
        for (int rep = 0; rep < REP_SAMP; ++rep)
        for (int q = bx; q < 512; q += G) hgrn_sample_unit(lds, q >> 2, q & 3, Qb, LFb, Vb, Gb, args.in[I_HGW], args.in[I_SH], MIX, NHS);
    }
    SEAM(3);
    if (IN(4)) hgrn_scan(DSg, EBLg, SFR, NHP, bx * NT + tid, G * NT);
    SEAM(4);
    if (IN(5)) { for (int u = bx; u < 1024; u += G) hgrn_pass3_unit(lds, u, QEb, OI, SFR, Gb, args.in[I_HGW], MIX); }
    SEAM(5);
    if (IN(6)) {
        pg8::Gemm g{MIX, WTout, M, D, D}; pg8::StaticOrder S; S.init(M, D, G, bx);
        pg8::EpiRes E{xp, xs, y, args.in[I_BOUT], MOD, 2048, ALPHA};
        pg8::gemm_phase<pg8::EpiRes, pg8::StaticOrder, true, true>(lds, g, S, E);
    }
    SEAM(6);
    if (IN(7)) ln_rows<true>(y, args.in[I_LN1G], args.in[I_LN1B], MOD, 3072, Hb, gw, ngw, lane);
    SEAM(7);
    if (IN(8)) {
        pg8::Gemm g{Hb, WTup, M, FF, D}; pg8::StaticOrder S; S.init(M, FF, G, bx);
        pg8::EpiUp E{HB, FF, args.in[I_BUP]};
        pg8::gemm_phase<pg8::EpiUp, pg8::StaticOrder, true, true>(lds, g, S, E);
    }
    SEAM(8);
    if (IN(9)) {
        pg8::Gemm g{HB, WTdn, M, D, FF}; pg8::StaticOrder S; S.init(M, D, G, bx);
        pg8::EpiRes E{y, y + (size_t)MP * D, y, args.in[I_BDN], MOD, 5120, ALPHA};
        pg8::gemm_phase<pg8::EpiRes, pg8::StaticOrder, true, true>(lds, g, S, E);
    }
    SEAM(9);
    if (IN(10)) ln_rows<false>(y, args.in[I_LN2G], args.in[I_LN2B], MOD, 0, nullptr, gw, ngw, lane);
#undef IN
#undef SEAM
}

#ifndef N_LAUNCH_MODE
#define N_LAUNCH_MODE 1
#endif
extern "C" void kernel_launch(void* const* d_in, const int* in_sizes, int n_in, void* d_out, int out_size, void* d_ws, size_t ws_size, hipStream_t stream) {
    static int grid = 0;
    if (grid == 0) {
        int dev = 0, cus = 0, per_cu = 0;
        if (n_in != 26 || ws_size < WS_END) { fprintf(stderr, "kernel_launch: unexpected n_in %d / ws %zu\n", n_in, ws_size); grid = -1; return; }
        if (hipGetDevice(&dev) != hipSuccess || hipDeviceGetAttribute(&cus, hipDeviceAttributeMultiprocessorCount, dev) != hipSuccess) { grid = -1; return; }
        if (hipFuncSetAttribute((const void*)fwd_kernel, hipFuncAttributeMaxDynamicSharedMemorySize, LDS_BYTES) != hipSuccess) { fprintf(stderr, "kernel_launch: hipFuncSetAttribute failed\n"); grid = -1; return; }
        if (hipOccupancyMaxActiveBlocksPerMultiprocessor(&per_cu, (const void*)fwd_kernel, NT, LDS_BYTES) != hipSuccess || per_cu < 1) per_cu = 1;
        (void)hipGetLastError();
        grid = cus * 1;
    }
    if (grid < 0) return;
    if (hipMemsetAsync((char*)d_ws + WS_CTL, 0, CTL_BYTES, stream) != hipSuccess) { fprintf(stderr, "kernel_launch: memset failed\n"); return; }
    Args a{};
    for (int i = 0; i < 26; ++i) a.in[i] = (const float*)d_in[i];
    a.out = (float*)d_out; a.ws = (unsigned char*)d_ws;
#if N_LAUNCH_MODE == 1
    a.ph_lo = 0; a.ph_hi = N_PHASES;
    void* kargs[] = {&a};
    hipError_t e = hipLaunchCooperativeKernel((const void*)fwd_kernel, dim3(grid), dim3(NT), kargs, LDS_BYTES, stream);
    if (e != hipSuccess) fprintf(stderr, "cooperative launch failed: %s (grid %d)\n", hipGetErrorString(e), grid);
#else
    for (int p = 0; p < N_PHASES; ++p) { a.ph_lo = p; a.ph_hi = p + 1; hipLaunchKernelGGL(fwd_kernel, dim3(grid), dim3(NT), LDS_BYTES, stream, a);
        if (p == PROBE_DUP) hipLaunchKernelGGL(fwd_kernel, dim3(grid), dim3(NT), LDS_BYTES, stream, a); }
#endif
}
```
